# Optimizing an MI355X kernel written in HIP

```python
import math
import jax
import jax.numpy as jnp
from jax import lax
import numpy as np

D_MODEL = 1024
BATCH = 8
SEQ = 4096
DEPTH = 2

GRID_W = 64
CTX_LEN = 256
N_SUB = 3
FF_HIDDEN = 2816
LN_EPS = 1e-5
RMS_EPS = 1e-5
DEEPNORM_ALPHA = (2 * DEPTH) ** 0.25
DEEPNORM_BETA = (8 * DEPTH) ** -0.25
N_EVEN = (DEPTH + 1) // 2
N_ODD = DEPTH // 2

RW_HEADS = 8
RW_HEAD = 64
RW_W = RW_HEADS * RW_HEAD
RW_DECAY_LORA = 64
RW_A_LORA = 64
RW_GATE_LORA = 160
RW_GN_EPS = 64e-5
RW_SPLITS = (RW_W, 2 * RW_W, 3 * RW_W, 3 * RW_W + 2 * RW_DECAY_LORA,
             3 * RW_W + 2 * RW_DECAY_LORA + RW_A_LORA)
A_TOTAL = 3 * RW_W + 2 * RW_DECAY_LORA + RW_A_LORA + RW_GATE_LORA

HG_HEADS = 4
HG_DK = 128
HG_DV = 128
HG_KW = HG_HEADS * HG_DK
HG_VW = HG_HEADS * HG_DV
HG_CHUNK = 64
HG_SPLITS = (HG_KW, 3 * HG_KW, 3 * HG_KW + HG_VW)
B_TOTAL = 3 * HG_KW + 2 * HG_VW
EVEN_PROJ = A_TOTAL + B_TOTAL
EVEN_MIX = RW_W + HG_VW

DA_HEADS = 8
DA_HEAD = 64
DA_W = DA_HEADS * 2 * DA_HEAD
Q_BLOCK = 128
ROPE_BASE = 10000.0

kernel_name = 'hybrid_rwkv7_hgrn2_diffattn_prefix_dit'


def _layernorm(t, g, b):
    tf = t.astype(jnp.float32)
    mu = jnp.mean(tf, axis=-1, keepdims=True)
    var = jnp.mean(jnp.square(tf - mu), axis=-1, keepdims=True)
    return (tf - mu) * lax.rsqrt(var + LN_EPS) * g + b


def _rmsnorm(t, g, eps):
    tf = t.astype(jnp.float32)
    return tf * lax.rsqrt(jnp.mean(tf * tf, axis=-1, keepdims=True) + eps) * g


def _modulation(cvec, w, b):
    m = jax.nn.silu(cvec) @ w + b
    return m.reshape(m.shape[:-1] + (N_SUB, 3, D_MODEL))


def _modulate(h, m, j):
    return h * (1.0 + m[..., j, 1, :]) + m[..., j, 0, :]


def _post_norm(h, out, gate, weight, g, b):
    return _layernorm(DEEPNORM_ALPHA * h + weight * gate * out, g, b)


def _swiglu(h, w_in, w_out):
    gt, up = jnp.split(h @ w_in, 2, axis=-1)
    return (jax.nn.silu(gt) * up) @ w_out


def _ffn_sublayer(h, m, j, w_in, w_out, g, b):
    out = _swiglu(_modulate(h, m, j), w_in, w_out)
    return _post_norm(h, out, m[..., j, 2, :], 0.5, g, b)


def _centred_shift(u):
    p = jnp.pad(u, ((0, 0), (1, 1), (0, 0)))
    return 0.5 * (p[:, :-2] + p[:, 2:])


def _rwkv7_prep(u, mu, w0, w2, a0, a2, g2, k_k, k_a):
    B, T, _ = u.shape
    u = u.astype(jnp.float32)
    u = u + mu * (_centred_shift(u) - u)
    r, k, v, wd, ad, gd = jnp.split(u, RW_SPLITS, axis=-1)
    wd = wd.reshape(B, T, 2, RW_DECAY_LORA)
    w = -jax.nn.softplus(-(w0 + jnp.einsum('btdr,drc->btdc', jnp.tanh(wd), w2))) - 0.5
    decay = jnp.exp(-jnp.exp(w)).reshape(B, T, 2, RW_HEADS, RW_HEAD)
    a = jax.nn.sigmoid(a0 + ad @ a2)
    g = jax.nn.sigmoid(gd) @ g2
    kk = (k * k_k).reshape(B, T, RW_HEADS, RW_HEAD)
    kk = kk / jnp.maximum(jnp.sqrt(jnp.sum(kk * kk, axis=-1, keepdims=True)), 1e-12)
    k = k * (1.0 + (a - 1.0) * k_a)
    heads = lambda t: t.reshape(B, T, RW_HEADS, RW_HEAD)
    return dict(r=heads(r), k=heads(k), v=heads(v), kk=kk, a=heads(a), decay=decay, g=g)


def _rwkv7_scan(s0, p, d, reverse):
    seq = lambda t: jnp.moveaxis(t, 1, 0)
    xs = (seq(p['r']), seq(p['decay'][:, :, d]), seq(p['k']), seq(p['v']),
          seq(-p['kk']), seq(p['kk'] * p['a']))

    def step(S, inp):
        r_t, w_t, k_t, v_t, z_t, b_t = inp
        sa = jnp.einsum('bhvk,bhk->bhv', S, z_t)
        S = S * w_t[:, :, None, :] + sa[..., None] * b_t[:, :, None, :] + v_t[..., None] * k_t[:, :, None, :]
        return S, jnp.einsum('bhvk,bhk->bhv', S, r_t)

    S, y = lax.scan(step, s0, xs, reverse=reverse)
    return S, jnp.moveaxis(y, 0, 1)


def _rwkv7_readout(y, p, r_k, gn_g, gn_b):
    B, T, H, N = y.shape
    mu = jnp.mean(y, axis=-1, keepdims=True)
    var = jnp.mean(jnp.square(y - mu), axis=-1, keepdims=True)
    y = (y - mu) * lax.rsqrt(var + RW_GN_EPS) * gn_g.reshape(H, N) + gn_b.reshape(H, N)
    y = y + jnp.sum(p['r'] * p['k'] * r_k, axis=-1, keepdims=True) * p['v']
    return y.reshape(B, T, H * N) * p['g']


def _rwkv7_mixer(u_ctx, u_lat, mu, w0, w2, a0, a2, g2, k_k, k_a, r_k, gn_g, gn_b, with_ctx_out):
    pc = _rwkv7_prep(u_ctx, mu, w0, w2, a0, a2, g2, k_k, k_a)
    pl = _rwkv7_prep(u_lat, mu, w0, w2, a0, a2, g2, k_k, k_a)
    B = u_lat.shape[0]
    s0 = jnp.zeros((B, RW_HEADS, RW_HEAD, RW_HEAD), jnp.float32)
    y_lat, y_ctx = 0.0, 0.0
    for d in range(2):
        s_ctx, yc = _rwkv7_scan(s0, pc, d, d == 1)
        _, yl = _rwkv7_scan(s_ctx, pl, d, d == 1)
        y_lat = y_lat + yl
        if with_ctx_out:
            y_ctx = y_ctx + yc
    out_lat = _rwkv7_readout(y_lat, pl, r_k, gn_g, gn_b)
    out_ctx = _rwkv7_readout(y_ctx, pc, r_k, gn_g, gn_b) if with_ctx_out else None
    return out_ctx, out_lat


def _hgrn2_prep(u, lb):
    B, T, _ = u.shape
    u = u.astype(jnp.float32)
    q, f, i, g = jnp.split(u, HG_SPLITS, axis=-1)
    fg = lb + (1.0 - lb) * jax.nn.sigmoid(f.reshape(B, T, 2, HG_KW))
    fg = fg.reshape(B, T, 2, HG_HEADS, HG_DK)
    return dict(q=jax.nn.silu(q).reshape(B, T, HG_HEADS, HG_DK), logf=jnp.log(fg), k=1.0 - fg,
                i=i.reshape(B, T, HG_HEADS, HG_DV), g=g.reshape(B, T, HG_HEADS, HG_DV))


def _gla_chunked(q, k, v, logf, s0):
    B, T, H, K = q.shape
    n, L = T // HG_CHUNK, HG_CHUNK
    q, k, v, logf = [t.reshape(B, n, L, H, -1) for t in (q, k, v, logf)]
    b = jnp.cumsum(logf, axis=2)
    b_last = b[:, :, -1]
    qb = q * jnp.exp(b)
    kb = k * jnp.exp(-b)
    kd = k * jnp.exp(b_last[:, :, None] - b)
    scores = jnp.einsum('bnlhk,bnshk->bnhls', qb, kb)
    scores = jnp.where(jnp.tril(jnp.ones((L, L), bool)), scores, 0.0)
    o_intra = jnp.einsum('bnhls,bnshv->bnlhv', scores, v)

    def step(S, inp):
        qb_c, kd_c, v_c, gl_c = inp
        o = jnp.einsum('blhk,bhkv->blhv', qb_c, S)
        S = S * gl_c[..., None] + jnp.einsum('blhk,blhv->bhkv', kd_c, v_c)
        return S, o

    xs = (jnp.moveaxis(qb, 1, 0), jnp.moveaxis(kd, 1, 0), jnp.moveaxis(v, 1, 0),
          jnp.moveaxis(jnp.exp(b_last), 1, 0))
    S, o_inter = lax.scan(step, s0, xs)
    o = o_intra + jnp.moveaxis(o_inter, 0, 1)
    return S, o.reshape(B, T, H, -1)


def _hgrn2_readout(o, p, norm_g):
    B, T = o.shape[:2]
    return (_rmsnorm(o, norm_g, RMS_EPS) * jax.nn.silu(p['g'])).reshape(B, T, HG_VW)


def _hgrn2_mixer(u_ctx, u_lat, lb, norm_g, with_ctx_out):
    pc = _hgrn2_prep(u_ctx, lb)
    pl = _hgrn2_prep(u_lat, lb)
    B = u_lat.shape[0]
    s0 = jnp.zeros((B, HG_HEADS, HG_DK, HG_DV), jnp.float32)
    o_lat, o_ctx = 0.0, 0.0
    for d in range(2):
        fl = (lambda t: jnp.flip(t, axis=1)) if d == 1 else (lambda t: t)
        s_ctx, oc = _gla_chunked(fl(pc['q']), fl(pc['k'][:, :, d]), fl(pc['i']), fl(pc['logf'][:, :, d]), s0)
        _, ol = _gla_chunked(fl(pl['q']), fl(pl['k'][:, :, d]), fl(pl['i']), fl(pl['logf'][:, :, d]), s_ctx)
        o_lat = o_lat + fl(ol)
        if with_ctx_out:
            o_ctx = o_ctx + fl(oc)
    out_lat = _hgrn2_readout(o_lat, pl, norm_g)
    out_ctx = _hgrn2_readout(o_ctx, pc, norm_g) if with_ctx_out else None
    return out_ctx, out_lat


def _even_mixer(h_ctx, h_lat, w_in, w_out, rw, lb, hg_norm_g, with_ctx_out):
    u_ctx = h_ctx @ w_in
    u_lat = h_lat @ w_in
    ra_ctx, ra_lat = _rwkv7_mixer(u_ctx[..., :A_TOTAL], u_lat[..., :A_TOTAL], *rw, with_ctx_out)
    hb_ctx, hb_lat = _hgrn2_mixer(u_ctx[..., A_TOTAL:], u_lat[..., A_TOTAL:], lb, hg_norm_g, with_ctx_out)
    out_lat = jnp.concatenate([ra_lat, hb_lat], axis=-1) @ w_out
    out_ctx = jnp.concatenate([ra_ctx, hb_ctx], axis=-1) @ w_out if with_ctx_out else None
    return out_ctx, out_lat


def _axial_rope_tables(n_tokens):
    n_rows = n_tokens // GRID_W
    row = jnp.repeat(jnp.arange(n_rows), GRID_W).astype(jnp.float32)
    col = jnp.tile(jnp.arange(GRID_W), n_rows).astype(jnp.float32)
    n_freq = DA_HEAD // 4
    inv = ROPE_BASE ** (-jnp.arange(n_freq, dtype=jnp.float32) / n_freq)
    ar = row[:, None] * inv
    ac = col[:, None] * inv
    ang = jnp.concatenate([ar, ar, ac, ac], axis=-1)
    return jnp.cos(ang), jnp.sin(ang)


def _rotate_half(t):
    h = t.shape[-1] // 2
    return jnp.concatenate([-t[..., h:], t[..., :h]], axis=-1)


def _apply_axial_rope(t, cos, sin):
    h = DA_HEAD // 2
    rot = jnp.concatenate([_rotate_half(t[..., :h]), _rotate_half(t[..., h:])], axis=-1)
    return t * cos[None, :, None, None, :] + rot * sin[None, :, None, None, :]


def _diff_split(u):
    B, T, _ = u.shape
    q, k, v = jnp.split(u, 3, axis=-1)
    return (q.reshape(B, T, DA_HEADS, 2, DA_HEAD), k.reshape(B, T, DA_HEADS, 2, DA_HEAD),
            v.reshape(B, T, DA_HEADS, 2 * DA_HEAD))


def _diff_softmax(q, k, v, lam):
    s = jnp.einsum('bqhmd,bshmd->bhmqs', q, k).astype(jnp.float32) * (DA_HEAD ** -0.5)
    p = jax.nn.softmax(s, axis=-1)
    a = p[:, :, 0] - lam * p[:, :, 1]
    return jnp.einsum('bhqs,bshe->bqhe', a, v.astype(jnp.float32))


def _diff_readout(o, norm_g, lam_init, w_out):
    B, T = o.shape[:2]
    o = _rmsnorm(o, norm_g, RMS_EPS) * (1.0 - lam_init)
    return o.reshape(B, T, DA_W) @ w_out


def _diff_attn_mixer(h_ctx, h_lat, w_in, w_out, lam_vecs, norm_g, lam_init, cos, sin, with_ctx_out):
    B, T, _ = h_lat.shape
    qc, kc, vc = _diff_split(h_ctx @ w_in)
    ql, kl, vl = _diff_split(h_lat @ w_in)
    ql = _apply_axial_rope(ql, cos, sin)
    kl = _apply_axial_rope(kl, cos, sin)
    lv = lam_vecs.astype(jnp.float32)
    lam = jnp.exp(jnp.sum(lv[0] * lv[1])) - jnp.exp(jnp.sum(lv[2] * lv[3])) + lam_init
    k_all = jnp.concatenate([kc, kl], axis=1)
    v_all = jnp.concatenate([vc, vl], axis=1)
    n_blk = T // Q_BLOCK
    q_blocks = jnp.moveaxis(ql.reshape(B, n_blk, Q_BLOCK, DA_HEADS, 2, DA_HEAD), 1, 0)
    o_lat = lax.map(lambda qb: _diff_softmax(qb, k_all, v_all, lam), q_blocks)
    o_lat = jnp.moveaxis(o_lat, 0, 1).reshape(B, T, DA_HEADS, 2 * DA_HEAD)
    out_lat = _diff_readout(o_lat, norm_g, lam_init, w_out)
    out_ctx = _diff_readout(_diff_softmax(qc, kc, vc, lam), norm_g, lam_init, w_out) if with_ctx_out else None
    return out_ctx, out_lat


def setup_inputs(seed: int = 0) -> dict:
    key = jax.random.key(seed)
    ks = jax.random.split(key, 29)
    D = D_MODEL
    nrm = lambda i, shape, scale: scale * jax.random.normal(ks[i], shape, jnp.float32)
    return {
        'x': nrm(0, (BATCH, SEQ, D), 1.0),
        'c': nrm(1, (BATCH, D), 1.0),
        'ctx': nrm(2, (BATCH, CTX_LEN, D), 1.0),
        'c_ctx': nrm(3, (D,), 1.0),
        'w_mod': nrm(4, (DEPTH, D, N_SUB * 3 * D), 0.5 * D ** -0.5),
        'b_mod': nrm(5, (DEPTH, N_SUB * 3 * D), 0.02),
        'ln_g': 1.0 + nrm(6, (DEPTH, N_SUB, D), 0.02),
        'ln_b': nrm(7, (DEPTH, N_SUB, D), 0.02),
        'ffn_w_in': nrm(8, (DEPTH, 2, D, 2 * FF_HIDDEN), D ** -0.5),
        'ffn_w_out': nrm(9, (DEPTH, 2, FF_HIDDEN, D), DEEPNORM_BETA * FF_HIDDEN ** -0.5),
        'ev_w_in': nrm(10, (N_EVEN, D, EVEN_PROJ), D ** -0.5),
        'ev_w_out': nrm(11, (N_EVEN, EVEN_MIX, D), DEEPNORM_BETA * EVEN_MIX ** -0.5),
        'rw_mu': jax.random.uniform(ks[12], (N_EVEN, A_TOTAL), jnp.float32),
        'rw_w0': jnp.linspace(-6.0, -1.0, RW_W, dtype=jnp.float32) + nrm(13, (N_EVEN, 2, RW_W), 0.1),
        'rw_w2': nrm(14, (N_EVEN, 2, RW_DECAY_LORA, RW_W), 0.1 * RW_DECAY_LORA ** -0.5),
        'rw_a0': nrm(15, (N_EVEN, RW_W), 0.1),
        'rw_a2': nrm(16, (N_EVEN, RW_A_LORA, RW_W), 0.1 * RW_A_LORA ** -0.5),
        'rw_g2': nrm(17, (N_EVEN, RW_GATE_LORA, RW_W), RW_GATE_LORA ** -0.5),
        'rw_k_k': 0.85 + nrm(18, (N_EVEN, RW_W), 0.05),
        'rw_k_a': 1.0 + nrm(19, (N_EVEN, RW_W), 0.05),
        'rw_r_k': nrm(20, (N_EVEN, RW_HEADS, RW_HEAD), 0.1),
        'rw_gn_g': 1.0 + nrm(21, (N_EVEN, RW_W), 0.02),
        'rw_gn_b': nrm(22, (N_EVEN, RW_W), 0.02),
        'hg_lb': nrm(23, (DEPTH + 1, HG_KW), 0.1),
        'hg_norm_g': 1.0 + nrm(24, (N_EVEN, HG_DV), 0.02),
        'od_w_in': nrm(25, (N_ODD, D, 3 * DA_W), D ** -0.5),
        'od_w_out': nrm(26, (N_ODD, DA_W, D), DEEPNORM_BETA * DA_W ** -0.5),
        'da_lambda': nrm(27, (N_ODD, 4, DA_HEAD), 0.1),
        'da_norm_g': 1.0 + nrm(28, (N_ODD, 2 * DA_HEAD), 0.02),
    }


def reference(x, c, ctx, c_ctx, w_mod, b_mod, ln_g, ln_b, ffn_w_in, ffn_w_out, ev_w_in, ev_w_out,
              rw_mu, rw_w0, rw_w2, rw_a0, rw_a2, rw_g2, rw_k_k, rw_k_a, rw_r_k, rw_gn_g, rw_gn_b,
              hg_lb, hg_norm_g, od_w_in, od_w_out, da_lambda, da_norm_g):
    T = x.shape[1]
    cos, sin = _axial_rope_tables(T)
    lower_bounds = jnp.cumsum(jax.nn.softmax(hg_lb.astype(jnp.float32), axis=0), axis=0)
    h_lat, h_ctx = x, ctx
    for i in range(DEPTH):
        with_ctx_out = i < DEPTH - 1
        j = i // 2
        m_lat = _modulation(c, w_mod[i], b_mod[i])[:, None]
        m_ctx = _modulation(c_ctx, w_mod[i], b_mod[i])[None, None]
        h_lat = _ffn_sublayer(h_lat, m_lat, 0, ffn_w_in[i, 0], ffn_w_out[i, 0], ln_g[i, 0], ln_b[i, 0])
        h_ctx = _ffn_sublayer(h_ctx, m_ctx, 0, ffn_w_in[i, 0], ffn_w_out[i, 0], ln_g[i, 0], ln_b[i, 0])
        a_lat = _modulate(h_lat, m_lat, 1)
        a_ctx = _modulate(h_ctx, m_ctx, 1)
        if i % 2 == 0:
            rw = (rw_mu[j], rw_w0[j], rw_w2[j], rw_a0[j], rw_a2[j], rw_g2[j], rw_k_k[j], rw_k_a[j],
                  rw_r_k[j], rw_gn_g[j], rw_gn_b[j])
            o_ctx, o_lat = _even_mixer(a_ctx, a_lat, ev_w_in[j], ev_w_out[j], rw, lower_bounds[i],
                                       hg_norm_g[j], with_ctx_out)
        else:
            lam_init = 0.8 - 0.6 * math.exp(-0.3 * i)
            o_ctx, o_lat = _diff_attn_mixer(a_ctx, a_lat, od_w_in[j], od_w_out[j], da_lambda[j], da_norm_g[j],
                                            lam_init, cos, sin, with_ctx_out)
        h_lat = _post_norm(h_lat, o_lat, m_lat[..., 1, 2, :], 1.0, ln_g[i, 1], ln_b[i, 1])
        h_lat = _ffn_sublayer(h_lat, m_lat, 2, ffn_w_in[i, 1], ffn_w_out[i, 1], ln_g[i, 2], ln_b[i, 2])
        if with_ctx_out:
            h_ctx = _post_norm(h_ctx, o_ctx, m_ctx[..., 1, 2, :], 1.0, ln_g[i, 1], ln_b[i, 1])
            h_ctx = _ffn_sublayer(h_ctx, m_ctx, 2, ffn_w_in[i, 1], ffn_w_out[i, 1], ln_g[i, 2], ln_b[i, 2])
    return h_lat
```

```cpp
#include <hip/hip_runtime.h>
#include <hip/hip_cooperative_groups.h>
#include <hip/hip_fp16.h>
#include <cstdio>
namespace cg = cooperative_groups;
#ifndef COOP
#define COOP 1
#endif
#define DI __device__ __forceinline__
namespace pg8 {
#define PG8_LAS __attribute__((address_space(3)))
typedef unsigned short bf16_t;
typedef short bf16x8 __attribute__((ext_vector_type(8)));
typedef float f32x4 __attribute__((ext_vector_type(4)));
typedef unsigned u32x4 __attribute__((ext_vector_type(4)));
constexpr int BM = 256, BK = 64, HALF = 128, HTB = HALF * BK * 2  , STAGE_BYTES = 8 * HTB, NXCD = 8, WGM = 8;

__host__ __device__ __forceinline__ int lds_byte(int r, int c) { const int st = (r >> 4) * 2 + (c >> 5), rr = r & 15, cc = c & 31, ob = rr * 64 + cc * 2; return st * 1024 + (ob ^ (((ob >> 9) & 1) << 5)); }
__host__ __device__ __forceinline__ void stage_rc(int b, int& R, int& C) { const int st = b / 1024, sb = b % 1024, swz = sb ^ (((sb >> 9) & 1) << 5); R = (st >> 1) * 16 + swz / 64; C = (st & 1) * 32 + (swz % 64) / 2; }
__host__ __device__ __forceinline__ int perm32(int rho) { const int n = rho >> 4, i = rho & 15; return 8 * (i >> 2) + 4 * n + (i & 3); }

struct Unit { int pm, pn; };
struct Gemm { const bf16_t* A; const bf16_t* Bt; int M, N, K; };

__device__ __forceinline__ unsigned cvt_pk_bf16(float lo, float hi) { unsigned r; asm volatile("v_cvt_pk_bf16_f32 %0, %1, %2" : "=v"(r) : "v"(lo), "v"(hi)); return r; }
typedef float f32x2 __attribute__((ext_vector_type(2)));
__device__ __forceinline__ f32x2 gelu_pk(f32x2 v) {
    const f32x2 av = __builtin_elementwise_abs(v), d = av * 0.2316418882f + 1.0f;
    f32x2 t; t.x = __builtin_amdgcn_rcpf(d.x); t.y = __builtin_amdgcn_rcpf(d.y);
    f32x2 q = t * 0.5307027145f + (-0.7265760135f); q = q * t + 0.7107068705f; q = q * t + (-0.142248368f); q = q * t + 0.127414796f; q = q * t;
    const f32x2 s = (v * v) * (-0.72134752044f);
    f32x2 e; e.x = __builtin_amdgcn_exp2f(s.x); e.y = __builtin_amdgcn_exp2f(s.y);
    const f32x2 m = v * (q * e), r = v - m;
    f32x2 o; o.x = v.x < 0.f ? m.x : r.x; o.y = v.y < 0.f ? m.y : r.y; return o;
}

struct EpiF32 {
    static constexpr bool PERM = false, AFTER_DRAIN = false;
    float* C; int ldc; const float* bias;
    __device__ __forceinline__ void operator()(const f32x4 (&acc)[2][2][4][2], const Unit& u, int wr, int wc, int fr, int fq) const {
        const int row0 = u.pm * BM + wr * 64 + fr, col0 = u.pn * BM + wc * 32 + 4 * fq;
        f32x4 bv[2][2];
#pragma unroll
        for (int bj = 0; bj < 2; ++bj)
#pragma unroll
            for (int n = 0; n < 2; ++n) bv[bj][n] = bias ? *(const f32x4*)(bias + col0 + bj * HALF + n * 16) : (f32x4){0.f, 0.f, 0.f, 0.f};
#pragma unroll
        for (int ai = 0; ai < 2; ++ai)
#pragma unroll
            for (int m = 0; m < 4; ++m) { float* rowp = C + (size_t)(row0 + ai * HALF + m * 16) * ldc + col0;
#pragma unroll
                for (int bj = 0; bj < 2; ++bj)
#pragma unroll
                    for (int n = 0; n < 2; ++n) *(f32x4*)(rowp + bj * HALF + n * 16) = acc[ai][bj][m][n] + bv[bj][n]; }
    }
};
template <int ACT  > struct EpiBf16 {
    static constexpr bool PERM = true, AFTER_DRAIN = false;
    bf16_t* O; int ldc; const float* bias; int split_cols; size_t split_stride;
    __device__ __forceinline__ void operator()(const f32x4 (&acc)[2][2][4][2], const Unit& u, int wr, int wc, int fr, int fq) const {
        const int row0 = u.pm * BM + wr * 64 + fr; int colt = u.pn * BM; bf16_t* base = O;
        if (split_cols) { const int t = colt / split_cols; base += (size_t)t * split_stride; colt -= t * split_cols; }
        const int col0 = colt + wc * 32 + 8 * fq, bcol0 = u.pn * BM + wc * 32 + 8 * fq;
        f32x4 bv[2][2];
#pragma unroll
        for (int bj = 0; bj < 2; ++bj)
#pragma unroll
            for (int n = 0; n < 2; ++n) bv[bj][n] = bias ? *(const f32x4*)(bias + bcol0 + bj * HALF + 4 * n) : (f32x4){0.f, 0.f, 0.f, 0.f};
#pragma unroll
        for (int ai = 0; ai < 2; ++ai)
#pragma unroll
            for (int m = 0; m < 4; ++m) { bf16_t* rowp = base + (size_t)(row0 + ai * HALF + m * 16) * ldc + col0;
#pragma unroll
                for (int bj = 0; bj < 2; ++bj) { f32x4 v0 = acc[ai][bj][m][0] + bv[bj][0], v1 = acc[ai][bj][m][1] + bv[bj][1];
                    if (ACT == 1) { f32x2 a = gelu_pk((f32x2){v0[0], v0[1]}), b = gelu_pk((f32x2){v0[2], v0[3]}), c = gelu_pk((f32x2){v1[0], v1[1]}), d = gelu_pk((f32x2){v1[2], v1[3]});
                        v0 = (f32x4){a.x, a.y, b.x, b.y}; v1 = (f32x4){c.x, c.y, d.x, d.y}; }
                    if (ACT == 2) {
#pragma unroll
                        for (int j = 0; j < 4; ++j) { v0[j] = 0.5f * v0[j] * (1.0f + erff(v0[j] * 0.70710678f)); v1[j] = 0.5f * v1[j] * (1.0f + erff(v1[j] * 0.70710678f)); } }
                    u32x4 w; w.x = cvt_pk_bf16(v0[0], v0[1]); w.y = cvt_pk_bf16(v0[2], v0[3]); w.z = cvt_pk_bf16(v1[0], v1[1]); w.w = cvt_pk_bf16(v1[2], v1[3]);
                    *(u32x4*)(rowp + bj * HALF) = w; } }
    }
};

template <class Epi, class Sched, bool STAMP = false>
__device__ __forceinline__ void gemm_phase(int tidx, PG8_LAS unsigned char* lds, const Gemm g, const Sched& S, const Epi& E, unsigned long long* stamps) {
    const int tid = tidx, wid = __builtin_amdgcn_readfirstlane(tid >> 6), lane = tid & 63, wr = wid >> 2, wc = wid & 3, fr = lane & 15, fq = lane >> 4;
    const int K = g.K, nt = K / BK;
    int ts_lo = 0, ts_hi = 0, nts = 0; const unsigned long long rt_entry = STAMP ? (unsigned long long)wall_clock64() : 0ull;
#define PG8_STAMP() do { if (STAMP && wid == 0 && nts < 64) { const unsigned long long _c = (unsigned long long)clock64(); \
        ts_lo = (lane == nts) ? (int)(unsigned)_c : ts_lo; ts_hi = (lane == nts) ? (int)(unsigned)(_c >> 32) : ts_hi; ++nts; } } while (0)
    PG8_STAMP();
    unsigned voffA[2], voffB[2];
#pragma unroll
    for (int i = 0; i < 2; ++i) { int R, C; stage_rc(tid * 16 + i * 8192, R, C); const int Rb = Epi::PERM ? ((R & ~31) + perm32(R & 31)) : R;
        voffA[i] = (unsigned)(R * K + C) * 2u; voffB[i] = (unsigned)(Rb * K + C) * 2u; }
    const size_t kstep = (size_t)(BK * 2);
    const size_t hstep = (size_t)HALF * K * 2;
    const size_t tstep = 2 * hstep;
    const unsigned ldsw = (unsigned)wid * 1024u;
    const int aoff = lds_byte(wr * 64 + fr, fq * 8), boff = lds_byte(wc * 32 + fr, fq * 8);
#define PG8_SA(b, h) (((b) * 2 + (h)) * HTB)
#define PG8_SB(b, h) ((4 + (b) * 2 + (h)) * HTB)
#define PG8_STAGE(bufoff, gbase, voff) do { _Pragma("unroll") for (int _i = 0; _i < 2; ++_i) \
        __builtin_amdgcn_global_load_lds((const unsigned*)((const char*)(gbase) + (voff)[_i]), (PG8_LAS unsigned*)(lds + (bufoff) + ldsw + _i * 8192), 16, 0, 0); } while (0)
#define PG8_LDA(dst, b, h) do { _Pragma("unroll") for (int m = 0; m < 4; ++m) _Pragma("unroll") for (int k = 0; k < 2; ++k) dst[m][k] = *(const PG8_LAS bf16x8*)(lds + PG8_SA(b, h) + aoff + m * 2048 + k * 1024); } while (0)
#define PG8_LDB(dst, b, h) do { _Pragma("unroll") for (int n = 0; n < 2; ++n) _Pragma("unroll") for (int k = 0; k < 2; ++k) dst[n][k] = *(const PG8_LAS bf16x8*)(lds + PG8_SB(b, h) + boff + n * 2048 + k * 1024); } while (0)
#define PG8_MMA(ai, bj, At, Bt) do { __builtin_amdgcn_s_setprio(1); _Pragma("unroll") for (int m = 0; m < 4; ++m) _Pragma("unroll") for (int n = 0; n < 2; ++n) _Pragma("unroll") for (int k = 0; k < 2; ++k) \
        acc[ai][bj][m][n] = __builtin_amdgcn_mfma_f32_16x16x32_bf16(Bt[n][k], At[m][k], acc[ai][bj][m][n], 0, 0, 0); __builtin_amdgcn_s_setprio(0); } while (0)
#define PG8_WAIT_V(n) asm volatile("s_waitcnt vmcnt(" #n ")" ::: "memory")
#define PG8_WAIT_L(n) asm volatile("s_waitcnt lgkmcnt(" #n ")" ::: "memory")
#define PG8_BAR __builtin_amdgcn_s_barrier()
#define PG8_SCHED __builtin_amdgcn_sched_barrier(0)
    Unit cur, nxt; int ui = 0;
    if (!S.next(0, cur)) return;
    f32x4 acc[2][2][4][2];
#pragma unroll
    for (int a = 0; a < 2; ++a)
#pragma unroll
        for (int b = 0; b < 2; ++b)
#pragma unroll
            for (int m = 0; m < 4; ++m)
#pragma unroll
                for (int n = 0; n < 2; ++n) acc[a][b][m][n] = (f32x4){0.f, 0.f, 0.f, 0.f};
    bf16x8 At[4][2], B0[2][2], B1[2][2];
    const char* cA = (const char*)g.A + (size_t)cur.pm * tstep; const char* cB = (const char*)g.Bt + (size_t)cur.pn * tstep;
    S.a_ready(cur);
    PG8_STAGE(PG8_SB(0, 0), cB, voffB); PG8_STAGE(PG8_SA(0, 0), cA, voffA); PG8_STAGE(PG8_SB(0, 1), cB + hstep, voffB); PG8_STAGE(PG8_SA(0, 1), cA + hstep, voffA);
    if (wr == 1) PG8_BAR;
    PG8_WAIT_V(4); PG8_BAR;
    PG8_STAGE(PG8_SB(1, 0), cB + kstep, voffB); PG8_STAGE(PG8_SA(1, 0), cA + kstep, voffA); PG8_STAGE(PG8_SB(1, 1), cB + hstep + kstep, voffB);
    PG8_WAIT_V(6); PG8_BAR;
    PG8_STAMP();
    for (;;) {
        const bool has_next = S.next(ui + 1, nxt);
        const char* nA = has_next ? (const char*)g.A + (size_t)nxt.pm * tstep : cA; const char* nB = has_next ? (const char*)g.Bt + (size_t)nxt.pn * tstep : cB;
        for (int t = 0; t < nt; t += 2) {
            const bool last = (t == nt - 2);
            const char* a1 = cA + (size_t)(t + 1) * kstep;
            const char* a2 = last ? nA : cA + (size_t)(t + 2) * kstep; const char* b2 = last ? nB : cB + (size_t)(t + 2) * kstep;
            const char* a3 = a2 + kstep; const char* b3 = b2 + kstep;
            if (last && has_next) S.a_ready(nxt);
            PG8_LDB(B0, 0, 0); PG8_SCHED; PG8_LDA(At, 0, 0); PG8_STAGE(PG8_SA(1, 1), a1 + hstep, voffA);
            PG8_WAIT_L(8); PG8_BAR; PG8_WAIT_L(0); PG8_MMA(0, 0, At, B0); PG8_BAR; PG8_SCHED;
            PG8_LDB(B1, 0, 1); PG8_STAGE(PG8_SB(0, 0), b2, voffB);
            PG8_BAR; PG8_WAIT_L(0); PG8_MMA(0, 1, At, B1); PG8_BAR;
            PG8_LDA(At, 0, 1); PG8_STAGE(PG8_SA(0, 0), a2, voffA);
            PG8_BAR; PG8_WAIT_L(0); PG8_MMA(1, 0, At, B0); PG8_BAR; PG8_SCHED;
            PG8_STAGE(PG8_SB(0, 1), b2 + hstep, voffB);
            PG8_WAIT_V(6); PG8_BAR; PG8_MMA(1, 1, At, B1); PG8_BAR;
            PG8_LDB(B0, 1, 0); PG8_SCHED; PG8_LDA(At, 1, 0); PG8_STAGE(PG8_SA(0, 1), a2 + hstep, voffA);
            PG8_WAIT_L(8); PG8_BAR; PG8_WAIT_L(0); PG8_MMA(0, 0, At, B0); PG8_BAR; PG8_SCHED;
            PG8_LDB(B1, 1, 1); PG8_STAGE(PG8_SB(1, 0), b3, voffB);
            PG8_BAR; PG8_WAIT_L(0); PG8_MMA(0, 1, At, B1); PG8_BAR;
            PG8_LDA(At, 1, 1); PG8_STAGE(PG8_SA(1, 0), a3, voffA);
            PG8_BAR; PG8_WAIT_L(0); PG8_MMA(1, 0, At, B0); PG8_BAR; PG8_SCHED;
            PG8_STAGE(PG8_SB(1, 1), b3 + hstep, voffB);
            PG8_WAIT_V(6); PG8_BAR; PG8_MMA(1, 1, At, B1); PG8_BAR;
        }
        PG8_STAMP();
        if constexpr (!Epi::AFTER_DRAIN) { E(acc, cur, wr, wc, fr, fq); S.done(cur); }
        PG8_STAMP();
        if (!has_next) break;
#pragma unroll
        for (int a = 0; a < 2; ++a)
#pragma unroll
            for (int b = 0; b < 2; ++b)
#pragma unroll
                for (int m = 0; m < 4; ++m)
#pragma unroll
                    for (int n = 0; n < 2; ++n) acc[a][b][m][n] = (f32x4){0.f, 0.f, 0.f, 0.f};
        cur = nxt; cA = nA; cB = nB; ++ui;
    }
    PG8_WAIT_V(0);
    if (wr == 0) PG8_BAR;
    PG8_BAR;
    if constexpr (Epi::AFTER_DRAIN) { E.fused(acc, cur, wr, wc, fr, fq, lds, wid, lane); S.done(cur); }
    PG8_STAMP();
    if (STAMP && wid == 0) { stamps[lane] = lane < nts ? (((unsigned long long)(unsigned)ts_hi << 32) | (unsigned)ts_lo) : 0ull;
        if (lane == 62) stamps[62] = rt_entry; if (lane == 63) stamps[63] = (unsigned long long)wall_clock64(); }
#undef PG8_STAMP
#undef PG8_SA
#undef PG8_SB
#undef PG8_STAGE
#undef PG8_LDA
#undef PG8_LDB
#undef PG8_MMA
#undef PG8_WAIT_V
#undef PG8_WAIT_L
#undef PG8_BAR
#undef PG8_SCHED
}
}

using pg8::bf16_t; using pg8::bf16x8; using pg8::f32x4; using pg8::u32x4; using pg8::Unit; using pg8::Gemm; using pg8::cvt_pk_bf16;
typedef float f32x16 __attribute__((ext_vector_type(16)));
typedef unsigned u32x2 __attribute__((ext_vector_type(2)));

constexpr int DM = 1024, FF = 2816, MROWS = 34816, MH = 17408, NLAT = 32768;
constexpr float ALPHA = 1.4142135623730951f;
constexpr float LAM_INIT = 0.35550907f;
constexpr float QSCALE = 0.18033688011112042f;
constexpr int LDS_BYTES = 131072;

constexpr size_t SZ_WFI = (size_t)5632 * 1024 * 2, SZ_WFO = (size_t)1024 * 2816 * 2;
constexpr size_t OFF_WFI = 0;
constexpr size_t OFF_WFO = OFF_WFI + 4 * SZ_WFI;
constexpr size_t OFF_WEI = OFF_WFO + 4 * SZ_WFO;
constexpr size_t OFF_WEO = OFF_WEI + (size_t)4608 * 1024 * 2;
constexpr size_t OFF_WOI = OFF_WEO + (size_t)1024 * 1024 * 2;
constexpr size_t OFF_WOO = OFF_WOI + (size_t)3072 * 1024 * 2;
constexpr size_t OFF_HCTX = OFF_WOO + (size_t)1024 * 1024 * 2;
constexpr size_t OFF_MODP = OFF_HCTX + (size_t)2048 * 1024 * 4;
constexpr size_t OFF_MODV = OFF_MODP + (size_t)8 * 2 * 9 * 9216 * 4;
constexpr size_t OFF_ROPE = OFF_MODV + (size_t)2 * 9 * 9216 * 4;
constexpr size_t OFF_MISC = OFF_ROPE + (size_t)4096 * 64 * 4;
constexpr size_t OFF_ABF = OFF_MISC + 4096;
constexpr size_t OFF_BIG = OFF_ABF + (size_t)MROWS * 1024 * 2;
constexpr size_t OFF_HID = OFF_BIG;
constexpr size_t OFF_OUTF = OFF_BIG + (size_t)MROWS * FF * 2;
constexpr size_t WS_NEED = OFF_OUTF + (size_t)MROWS * 1024 * 4;
constexpr size_t SZ_PU = (size_t)MH * 512 * 2;
constexpr size_t OFF_U = OFF_BIG;
constexpr size_t OFF_PR = OFF_U + (size_t)MH * 4608 * 2;
constexpr size_t OFF_PK = OFF_PR + SZ_PU, OFF_PV = OFF_PK + SZ_PU, OFF_PKK = OFF_PV + SZ_PU, OFF_PBB = OFF_PKK + SZ_PU;
constexpr size_t OFF_PEW = OFF_PBB + SZ_PU;
constexpr size_t OFF_PG = OFF_PEW + 2 * SZ_PU;
constexpr size_t OFF_Y0 = OFF_PG + SZ_PU, OFF_Y1 = OFF_Y0 + SZ_PU;
constexpr size_t OFF_O0 = OFF_PR, OFF_O1 = OFF_PK;
constexpr size_t OFF_U3 = OFF_BIG;
constexpr size_t OFF_VT = OFF_U3 + (size_t)MROWS * 3072 * 2;

struct ParamsS {
    const float *x, *c, *ctx, *cctx, *w_mod, *b_mod, *ln_g, *ln_b, *ffn_w_in, *ffn_w_out, *ev_w_in, *ev_w_out, *rw_mu, *rw_w0, *rw_w2, *rw_a0, *rw_a2, *rw_g2,
        *rw_k_k, *rw_k_a, *rw_r_k, *rw_gn_g, *rw_gn_b, *hg_lb, *hg_norm_g, *od_w_in, *od_w_out, *da_lambda, *da_norm_g;
    float* out;
    char* ws;
};
typedef const __attribute__((address_space(4))) ParamsS Params;

DI float bf2f(bf16_t v) { return __uint_as_float((unsigned)v << 16); }
DI bf16_t f2bf(float f) { unsigned u = __float_as_uint(f); u += 0x7FFFu + ((u >> 16) & 1u); return (bf16_t)(u >> 16); }
DI float lo2f(unsigned w) { return __uint_as_float(w << 16); }
DI float hi2f(unsigned w) { return __uint_as_float(w & 0xFFFF0000u); }
DI float sigmoidf_(float x) { return 1.f / (1.f + __expf(-x)); }
DI float wave_sum(float v) {
#pragma unroll
    for (int o = 32; o >= 1; o >>= 1) v += __shfl_xor(v, o, 64);
    return v;
}
DI float dpp_sum16(float x) {
    x += __int_as_float(__builtin_amdgcn_update_dpp(0, __float_as_int(x), 0xB1, 0xF, 0xF, true));
    x += __int_as_float(__builtin_amdgcn_update_dpp(0, __float_as_int(x), 0x4E, 0xF, 0xF, true));
    x += __int_as_float(__builtin_amdgcn_update_dpp(0, __float_as_int(x), 0x141, 0xF, 0xF, true));
    x += __int_as_float(__builtin_amdgcn_update_dpp(0, __float_as_int(x), 0x140, 0xF, 0xF, true));
    return x;
}
DI void row_info(int rho, int& b, int& t, int& isctx) {
    const int half = rho >= MH ? 1 : 0; int q = rho - half * MH;
    if (q < 16384) { isctx = 0; b = half * 4 + (q >> 12); t = q & 4095; }
    else { q -= 16384; isctx = 1; b = half * 4 + (q >> 8); t = q & 255; }
}
DI float* h_ptr(Params& p, int b, int t, int isctx) {
    return isctx ? (float*)(p.ws + OFF_HCTX) + ((size_t)b * 256 + t) * 1024 : p.out + ((size_t)b * 4096 + t) * 1024;
}
DI const float* in_ptr(Params& p, int b, int t, int isctx) {
    return isctx ? p.ctx + ((size_t)b * 256 + t) * 1024 : p.x + ((size_t)b * 4096 + t) * 1024;
}

struct Order {
    int nM, nN, nwg, G, c, skipctx;
    DI void init(int M, int N, int G_, int c_, int skip) { nM = M / 256; nN = N / 256; nwg = nM * nN; G = G_; c = c_; skipctx = skip; }
    DI bool next(int i, Unit& u) const {
        const long L = (long)i * G + c; if (L >= nwg) return false;
        int wgid = (int)L; { const int q = nwg / 8, r = nwg % 8, xcd = wgid % 8, off = wgid / 8; wgid = (xcd < r ? xcd * (q + 1) : r * (q + 1) + (xcd - r) * q) + off; }
        const int nig = 8 * nN, gid = wgid / nig, fm = gid * 8, gsz = (nM - fm) < 8 ? (nM - fm) : 8;
        u.pm = fm + ((wgid % nig) % gsz); u.pn = (wgid % nig) / gsz;
        if (skipctx) u.pm += 4 * (u.pm >> 6);
        return true;
    }
    DI void a_ready(const Unit&) const {}
    DI void done(const Unit&) const {}
};

struct EpiSwiglu {
    static constexpr bool PERM = true, AFTER_DRAIN = false;
    bf16_t* O; int ldc;
    DI void operator()(const f32x4 (&acc)[2][2][4][2], const Unit& u, int wr, int wc, int fr, int fq) const {
        const int row0 = u.pm * 256 + wr * 64 + fr; const int col0 = (u.pn * 256 + wc * 32 + 8 * fq) >> 1;
#pragma unroll
        for (int ai = 0; ai < 2; ++ai)
#pragma unroll
            for (int m = 0; m < 4; ++m) { bf16_t* rowp = O + (size_t)(row0 + ai * 128 + m * 16) * ldc + col0;
#pragma unroll
                for (int bj = 0; bj < 2; ++bj) { const f32x4 v0 = acc[ai][bj][m][0], v1 = acc[ai][bj][m][1];
                    const float h0 = v0[0] * sigmoidf_(v0[0]) * v0[1], h1 = v0[2] * sigmoidf_(v0[2]) * v0[3];
                    const float h2 = v1[0] * sigmoidf_(v1[0]) * v1[1], h3 = v1[2] * sigmoidf_(v1[2]) * v1[3];
                    u32x2 w; w.x = cvt_pk_bf16(h0, h1); w.y = cvt_pk_bf16(h2, h3);
                    *(u32x2*)(rowp + bj * 64) = w; } }
    }
};

DI void conv_tile(int tidx, const float* src, int Nsrc, int K, bf16_t* dst, int kind, int tile, float* lds) {
    const int nkt = K >> 6; const int nt = tile / nkt, kt = tile - nt * nkt; const int n0 = nt * 64, k0 = kt * 64;
    const int nn = tidx & 63, kq = tidx >> 6; const int n = n0 + nn; int col;
    if (kind == 1) col = (n & 1) ? (FF + (n >> 1)) : (n >> 1);
    else if (kind == 2) col = n < 1888 ? n : (n < 2048 ? -1 : n - 160);
    else col = n;
    __syncthreads();
#pragma unroll
    for (int i = 0; i < 8; ++i) { const int kk = kq + 8 * i; lds[kk * 65 + nn] = col >= 0 ? src[(size_t)(k0 + kk) * Nsrc + col] : 0.f; }
    __syncthreads();
    const int n2 = tidx >> 3, ks = tidx & 7; const float* l = lds + (ks * 8) * 65 + n2;
    u32x4 w; w.x = cvt_pk_bf16(l[0], l[65]); w.y = cvt_pk_bf16(l[130], l[195]); w.z = cvt_pk_bf16(l[260], l[325]); w.w = cvt_pk_bf16(l[390], l[455]);
    *(u32x4*)(dst + (size_t)(n0 + n2) * K + k0 + ks * 8) = w;
}

DI void phase_pre(int tidx, int bidx, Params& p, float* lds) {
    const int tid = tidx;
    float* part = (float*)(p.ws + OFF_MODP);
    for (int u = bidx; u < 288; u += gridDim.x) {
        const int ks = u & 7, ct = (u >> 3) % 18, layer = u / 144;
        __syncthreads();
        for (int i = tid; i < 9 * 128; i += 512) { const int r = i >> 7, k = i & 127; const float cv = r < 8 ? p.c[r * 1024 + ks * 128 + k] : p.cctx[ks * 128 + k]; lds[i] = cv / (1.f + expf(-cv)); }
        __syncthreads();
        const int col = ct * 512 + tid; const float* w = p.w_mod + ((size_t)layer * 1024 + ks * 128) * 9216 + col;
        float a0 = 0, a1 = 0, a2 = 0, a3 = 0, a4 = 0, a5 = 0, a6 = 0, a7 = 0, a8 = 0;
#pragma unroll 4
        for (int k = 0; k < 128; ++k) { const float wv = w[(size_t)k * 9216];
            a0 += lds[k] * wv; a1 += lds[128 + k] * wv; a2 += lds[256 + k] * wv; a3 += lds[384 + k] * wv; a4 += lds[512 + k] * wv; a5 += lds[640 + k] * wv; a6 += lds[768 + k] * wv; a7 += lds[896 + k] * wv; a8 += lds[1024 + k] * wv; }
        float* o = part + ((size_t)(ks * 2 + layer) * 9) * 9216 + col;
        o[0] = a0; o[9216] = a1; o[2 * 9216] = a2; o[3 * 9216] = a3; o[4 * 9216] = a4; o[5 * 9216] = a5; o[6 * 9216] = a6; o[7 * 9216] = a7; o[8 * 9216] = a8;
    }
    for (int tI = bidx; tI < 10880; tI += gridDim.x) {
        if (tI < 5632) { const int w = tI / 1408; conv_tile(tidx, p.ffn_w_in + (size_t)w * 1024 * 5632, 5632, 1024, (bf16_t*)(p.ws + OFF_WFI + w * SZ_WFI), 1, tI - w * 1408, lds); }
        else if (tI < 8448) { const int q = tI - 5632, w = q / 704; conv_tile(tidx, p.ffn_w_out + (size_t)w * 2816 * 1024, 1024, 2816, (bf16_t*)(p.ws + OFF_WFO + w * SZ_WFO), 0, q - w * 704, lds); }
        else if (tI < 9600) conv_tile(tidx, p.ev_w_in, 4448, 1024, (bf16_t*)(p.ws + OFF_WEI), 2, tI - 8448, lds);
        else if (tI < 9856) conv_tile(tidx, p.ev_w_out, 1024, 1024, (bf16_t*)(p.ws + OFF_WEO), 0, tI - 9600, lds);
        else if (tI < 10624) conv_tile(tidx, p.od_w_in, 3072, 1024, (bf16_t*)(p.ws + OFF_WOI), 0, tI - 9856, lds);
        else conv_tile(tidx, p.od_w_out, 1024, 1024, (bf16_t*)(p.ws + OFF_WOO), 0, tI - 10624, lds);
    }
    float* rope = (float*)(p.ws + OFF_ROPE);
    for (int i = bidx * 512 + tid; i < 4096 * 32; i += gridDim.x * 512) {
        const int t = i >> 5, f = i & 31; const float pos = (float)((f < 16) ? (t >> 6) : (t & 63));
        const float inv = powf(10000.0f, -(float)(f & 15) / 16.0f); const float ang = pos * inv;
        rope[t * 64 + f] = (float)cos((double)ang); rope[t * 64 + 32 + f] = (float)sin((double)ang);
    }
    if (bidx == 0) {
        float* misc = (float*)(p.ws + OFF_MISC);
        { const float l0 = p.hg_lb[tid], l1 = p.hg_lb[512 + tid], l2 = p.hg_lb[1024 + tid]; const float mx = fmaxf(l0, fmaxf(l1, l2));
          const float e0 = expf(l0 - mx), e1 = expf(l1 - mx), e2 = expf(l2 - mx); misc[tid] = e0 / (e0 + e1 + e2); }
        if (tid < 64) { const float s01 = wave_sum(p.da_lambda[tid] * p.da_lambda[64 + tid]); const float s23 = wave_sum(p.da_lambda[128 + tid] * p.da_lambda[192 + tid]);
            if (tid == 0) misc[512] = expf(s01) - expf(s23) + LAM_INIT; }
    }
}

DI void phase_modfin(int tidx, int bidx, Params& p) {
    const float* part = (const float*)(p.ws + OFF_MODP); float* mv = (float*)(p.ws + OFF_MODV);
    for (int i = bidx * 512 + tidx; i < 2 * 9 * 9216; i += gridDim.x * 512) {
        const int layer = i / (9 * 9216); const int col = i % 9216; float s = p.b_mod[layer * 9216 + col];
#pragma unroll
        for (int ks = 0; ks < 8; ++ks) s += part[(size_t)ks * 2 * 9 * 9216 + i];
        mv[i] = s;
    }
}

DI void phase_modin(int tidx, int bidx, Params& p) {
    const int wid = tidx >> 6, lane = tidx & 63; const float* mv = (const float*)(p.ws + OFF_MODV); bf16_t* abf = (bf16_t*)(p.ws + OFF_ABF);
    for (int rho = bidx * 8 + wid; rho < MROWS; rho += gridDim.x * 8) {
        int b, t, ic; row_info(rho, b, t, ic); const float* src = in_ptr(p, b, t, ic); const float* m = mv + (size_t)(ic ? 8 : b) * 9216;
#pragma unroll
        for (int i = 0; i < 4; ++i) { const int d = i * 256 + lane * 4; const f32x4 h = *(const f32x4*)(src + d), sh = *(const f32x4*)(m + d), sc = *(const f32x4*)(m + 1024 + d);
            u32x2 w; w.x = cvt_pk_bf16(h[0] * (1.f + sc[0]) + sh[0], h[1] * (1.f + sc[1]) + sh[1]); w.y = cvt_pk_bf16(h[2] * (1.f + sc[2]) + sh[2], h[3] * (1.f + sc[3]) + sh[3]);
            *(u32x2*)(abf + (size_t)rho * 1024 + d) = w; }
    }
}

DI void phase_postnorm(int tidx, int bidx, Params& p, int layer, int j, float wgt, int first, int nl, int nj, int skipctx) {
    const int wid = tidx >> 6, lane = tidx & 63; const float* mv = (const float*)(p.ws + OFF_MODV); bf16_t* abf = (bf16_t*)(p.ws + OFF_ABF);
    const float* outf = (const float*)(p.ws + OFF_OUTF); const float* lg = p.ln_g + (layer * 3 + j) * 1024; const float* lb = p.ln_b + (layer * 3 + j) * 1024;
    for (int rho = bidx * 8 + wid; rho < MROWS; rho += gridDim.x * 8) {
        int b, t, ic; row_info(rho, b, t, ic); if (skipctx && ic) continue;
        const float* hp = first ? in_ptr(p, b, t, ic) : h_ptr(p, b, t, ic); float* hd = h_ptr(p, b, t, ic);
        const float* m = mv + ((size_t)layer * 9 + (ic ? 8 : b)) * 9216 + j * 3072 + 2048; const float* o = outf + (size_t)rho * 1024;
        f32x4 v[4]; float s = 0.f;
#pragma unroll
        for (int i = 0; i < 4; ++i) { const int d = i * 256 + lane * 4; const f32x4 h = *(const f32x4*)(hp + d), g = *(const f32x4*)(m + d), ov = *(const f32x4*)(o + d);
            v[i] = ALPHA * h + wgt * g * ov; s += v[i][0] + v[i][1] + v[i][2] + v[i][3]; }
        const float mu = wave_sum(s) * (1.f / 1024.f); float q = 0.f;
#pragma unroll
        for (int i = 0; i < 4; ++i) { v[i] = v[i] - mu; q += v[i][0] * v[i][0] + v[i][1] * v[i][1] + v[i][2] * v[i][2] + v[i][3] * v[i][3]; }
        const float rs = rsqrtf(wave_sum(q) * (1.f / 1024.f) + 1e-5f);
        const float* m2 = nl >= 0 ? mv + ((size_t)nl * 9 + (ic ? 8 : b)) * 9216 + nj * 3072 : mv;
#pragma unroll
        for (int i = 0; i < 4; ++i) { const int d = i * 256 + lane * 4; const f32x4 hn = v[i] * rs * *(const f32x4*)(lg + d) + *(const f32x4*)(lb + d);
            *(f32x4*)(hd + d) = hn;
            if (nl >= 0) { const f32x4 sh = *(const f32x4*)(m2 + d), sc = *(const f32x4*)(m2 + 1024 + d);
                u32x2 w; w.x = cvt_pk_bf16(hn[0] * (1.f + sc[0]) + sh[0], hn[1] * (1.f + sc[1]) + sh[1]); w.y = cvt_pk_bf16(hn[2] * (1.f + sc[2]) + sh[2], hn[3] * (1.f + sc[3]) + sh[3]);
                *(u32x2*)(abf + (size_t)rho * 1024 + d) = w; } }
    }
}

DI float shifted(const bf16_t* U, size_t r, int col, int t, int T, float mu) {
    const float cur = bf2f(U[r * 4608 + col]); const float prev = t > 0 ? bf2f(U[(r - 1) * 4608 + col]) : 0.f; const float nxt = t < T - 1 ? bf2f(U[(r + 1) * 4608 + col]) : 0.f;
    return cur + mu * (0.5f * (prev + nxt) - cur);
}
#define LORA_ACC(W, J, JB) do { _Pragma("unroll") for (int q = 0; q < 32; ++q) acc[q] = 0.f; \
    for (int jj = 0; jj < (J); ++jj) { const float wv = (W)[jj * 512 + c]; const f32x4* in4 = (const f32x4*)(lds + ((JB) + jj) * 32); \
        _Pragma("unroll") for (int q = 0; q < 8; ++q) { const f32x4 xv = in4[q]; acc[4 * q] += wv * xv[0]; acc[4 * q + 1] += wv * xv[1]; acc[4 * q + 2] += wv * xv[2]; acc[4 * q + 3] += wv * xv[3]; } } } while (0)

DI void phase_rwprep(int tidx, int bidx, Params& p, float* lds) {
    const int tid = tidx, c = tid; const bf16_t* U = (const bf16_t*)(p.ws + OFF_U);
    bf16_t* PR = (bf16_t*)(p.ws + OFF_PR); bf16_t* PK = (bf16_t*)(p.ws + OFF_PK); bf16_t* PV = (bf16_t*)(p.ws + OFF_PV); bf16_t* PKK = (bf16_t*)(p.ws + OFF_PKK); bf16_t* PBB = (bf16_t*)(p.ws + OFF_PBB);
    __half* PEW = (__half*)(p.ws + OFF_PEW); bf16_t* PG = (bf16_t*)(p.ws + OFF_PG);
    const float mur = p.rw_mu[c], muk = p.rw_mu[512 + c], muv = p.rw_mu[1024 + c], kkc = p.rw_k_k[c], kac = p.rw_k_a[c], a0c = p.rw_a0[c], w00 = p.rw_w0[c], w01 = p.rw_w0[512 + c];
    for (int tile = bidx; tile < 544; tile += gridDim.x) {
        int row0, t0, T;
        if (tile < 512) { row0 = tile * 32; t0 = row0 & 4095; T = 4096; } else { row0 = 16384 + (tile - 512) * 32; t0 = ((tile - 512) * 32) & 255; T = 256; }
        __syncthreads();
        for (int i = tid; i < 352 * 32; i += 512) { const int tok = i / 352, j = i - tok * 352; const int col = 1536 + j;
            const float xs = shifted(U, (size_t)(row0 + tok), col, t0 + tok, T, p.rw_mu[col]);
            lds[j * 32 + tok] = j < 128 ? tanhf(xs) : (j < 192 ? xs : sigmoidf_(xs)); }
        __syncthreads();
        float acc[32]; float* lla = lds + 352 * 32;
        LORA_ACC(p.rw_a2, 64, 128);
#pragma unroll
        for (int q = 0; q < 32; ++q) lla[q * 512 + c] = sigmoidf_(a0c + acc[q]);
        LORA_ACC(p.rw_w2, 64, 0);
#pragma unroll
        for (int q = 0; q < 32; ++q) PEW[((size_t)(row0 + q) * 2 + 0) * 512 + c] = __float2half(0.6065306597126334f * sigmoidf_(w00 + acc[q]));
        LORA_ACC(p.rw_w2 + 64 * 512, 64, 64);
#pragma unroll
        for (int q = 0; q < 32; ++q) PEW[((size_t)(row0 + q) * 2 + 1) * 512 + c] = __float2half(0.6065306597126334f * sigmoidf_(w01 + acc[q]));
        LORA_ACC(p.rw_g2, 160, 192);
#pragma unroll
        for (int q = 0; q < 32; ++q) PG[(size_t)(row0 + q) * 512 + c] = f2bf(acc[q]);
#pragma unroll 2
        for (int q = 0; q < 32; ++q) { const size_t r = (size_t)(row0 + q); const int t = t0 + q;
            const float rr = shifted(U, r, c, t, T, mur), kr = shifted(U, r, 512 + c, t, T, muk), vr = shifted(U, r, 1024 + c, t, T, muv);
            const float kkv = kr * kkc; const float ss = wave_sum(kkv * kkv); const float kk = kkv / fmaxf(sqrtf(ss), 1e-12f); const float a = lla[q * 512 + c];
            PR[r * 512 + c] = f2bf(rr); PK[r * 512 + c] = f2bf(kr * (1.f + (a - 1.f) * kac)); PV[r * 512 + c] = f2bf(vr); PKK[r * 512 + c] = f2bf(kk); PBB[r * 512 + c] = f2bf(kk * a); }
    }
}

DI int scan_row(int gs, int bl, int d) {
    if (gs < 256) return 16384 + bl * 256 + (d ? 255 - gs : gs);
    const int t = gs - 256; return bl * 4096 + (d ? 4095 - t : t);
}
DI void cvt8(const u32x4 w, float* o) { o[0] = lo2f(w.x); o[1] = hi2f(w.x); o[2] = lo2f(w.y); o[3] = hi2f(w.y); o[4] = lo2f(w.z); o[5] = hi2f(w.z); o[6] = lo2f(w.w); o[7] = hi2f(w.w); }

DI void phase_rwscan(int tidx, int bidx, Params& p, float* lds) {
    const int tid = tidx; constexpr int ST = 340, BUF = 32 * ST;
    const bf16_t* PR = (const bf16_t*)(p.ws + OFF_PR); const bf16_t* PK = (const bf16_t*)(p.ws + OFF_PK); const bf16_t* PV = (const bf16_t*)(p.ws + OFF_PV);
    const bf16_t* PKK = (const bf16_t*)(p.ws + OFF_PKK); const bf16_t* PBB = (const bf16_t*)(p.ws + OFF_PBB); const __half* PEW = (const __half*)(p.ws + OFF_PEW);
    for (int unit = bidx; unit < 256; unit += gridDim.x) {
        const int rq = unit & 3, scan = unit >> 2; const int d = scan & 1, h = (scan >> 1) & 7, bl = scan >> 4;
        bf16_t* Y = (bf16_t*)(p.ws + (d ? OFF_Y1 : OFF_Y0));
        __syncthreads();
        float S0 = 0.f, S1 = 0.f, S2 = 0.f, S3 = 0.f;
        const int lane = tid & 63, ks = lane & 15, rowl = ((tid >> 6) & 3) * 4 + (lane >> 4);
        for (int ch = -1; ch < 136; ++ch) {
            if (tid >= 256) {
                if (ch + 1 < 136) {
                    const int i = tid - 256, step = i >> 3, grp = i & 7; float* dst = lds + ((ch + 1) & 1) * BUF + step * ST;
                    const int row = scan_row((ch + 1) * 32 + step, bl, d); const size_t o = (size_t)row * 512 + h * 64 + grp * 8;
                    const u32x4 r8 = *(const u32x4*)(PR + o), k8 = *(const u32x4*)(PK + o), z8 = *(const u32x4*)(PKK + o), b8 = *(const u32x4*)(PBB + o);
                    const u32x4 e8 = *(const u32x4*)(PEW + ((size_t)row * 2 + d) * 512 + h * 64 + grp * 8);
                    const unsigned v2 = *(const unsigned*)(PV + (size_t)row * 512 + h * 64 + rq * 16 + grp * 2);
                    float f[8];
                    cvt8(r8, f); *(f32x4*)(dst + grp * 8) = (f32x4){f[0], f[1], f[2], f[3]}; *(f32x4*)(dst + grp * 8 + 4) = (f32x4){f[4], f[5], f[6], f[7]};
                    { const __half2* e2 = (const __half2*)&e8;
#pragma unroll
                      for (int q = 0; q < 4; ++q) { const float2 ef = __half22float2(e2[q]); f[2 * q] = __expf(-ef.x); f[2 * q + 1] = __expf(-ef.y); } }
                    *(f32x4*)(dst + 64 + grp * 8) = (f32x4){f[0], f[1], f[2], f[3]}; *(f32x4*)(dst + 64 + grp * 8 + 4) = (f32x4){f[4], f[5], f[6], f[7]};
                    cvt8(k8, f); *(f32x4*)(dst + 128 + grp * 8) = (f32x4){f[0], f[1], f[2], f[3]}; *(f32x4*)(dst + 128 + grp * 8 + 4) = (f32x4){f[4], f[5], f[6], f[7]};
                    cvt8(z8, f); *(f32x4*)(dst + 192 + grp * 8) = (f32x4){-f[0], -f[1], -f[2], -f[3]}; *(f32x4*)(dst + 192 + grp * 8 + 4) = (f32x4){-f[4], -f[5], -f[6], -f[7]};
                    cvt8(b8, f); *(f32x4*)(dst + 256 + grp * 8) = (f32x4){f[0], f[1], f[2], f[3]}; *(f32x4*)(dst + 256 + grp * 8 + 4) = (f32x4){f[4], f[5], f[6], f[7]};
                    dst[320 + grp * 2] = lo2f(v2); dst[320 + grp * 2 + 1] = hi2f(v2);
                    if (grp == 0) ((int*)dst)[336] = row;
                }
            } else if (ch >= 0) {
                const float* buf = lds + (ch & 1) * BUF;
                for (int s = 0; s < 32; ++s) {
                    const float* bp = buf + s * ST;
                    const f32x4 r4 = *(const f32x4*)(bp + ks * 4), w4 = *(const f32x4*)(bp + 64 + ks * 4), k4 = *(const f32x4*)(bp + 128 + ks * 4), z4 = *(const f32x4*)(bp + 192 + ks * 4), b4 = *(const f32x4*)(bp + 256 + ks * 4);
                    const float vv = bp[320 + rowl]; const int row = ((const int*)bp)[336];
                    const float sa = dpp_sum16(S0 * z4[0] + S1 * z4[1] + S2 * z4[2] + S3 * z4[3]);
                    S0 = S0 * w4[0] + (sa * b4[0] + vv * k4[0]); S1 = S1 * w4[1] + (sa * b4[1] + vv * k4[1]); S2 = S2 * w4[2] + (sa * b4[2] + vv * k4[2]); S3 = S3 * w4[3] + (sa * b4[3] + vv * k4[3]);
                    const float y = dpp_sum16(S0 * r4[0] + S1 * r4[1] + S2 * r4[2] + S3 * r4[3]);
                    if (ks == 0) Y[(size_t)row * 512 + h * 64 + rq * 16 + rowl] = f2bf(y);
                }
            }
            __syncthreads();
        }
    }
}

DI void phase_rwread(int tidx, int bidx, Params& p, int half) {
    const int c = tidx; const bf16_t* PR = (const bf16_t*)(p.ws + OFF_PR); const bf16_t* PK = (const bf16_t*)(p.ws + OFF_PK); const bf16_t* PV = (const bf16_t*)(p.ws + OFF_PV);
    const bf16_t* PG = (const bf16_t*)(p.ws + OFF_PG); const bf16_t* Y0 = (const bf16_t*)(p.ws + OFF_Y0); const bf16_t* Y1 = (const bf16_t*)(p.ws + OFF_Y1);
    bf16_t* mix = (bf16_t*)(p.ws + OFF_ABF) + (size_t)half * MH * 1024;
    const float gg = p.rw_gn_g[c], gb = p.rw_gn_b[c], rk = p.rw_r_k[c];
    for (int r = bidx; r < MH; r += gridDim.x) {
        const size_t o = (size_t)r * 512 + c; const float y = bf2f(Y0[o]) + bf2f(Y1[o]);
        const float mu = wave_sum(y) * (1.f / 64.f); const float dy = y - mu; const float var = wave_sum(dy * dy) * (1.f / 64.f);
        const float rr = bf2f(PR[o]), kk = bf2f(PK[o]), vv = bf2f(PV[o]); const float s = wave_sum(rr * kk * rk);
        const float val = (dy * rsqrtf(var + 64e-5f) * gg + gb + s * vv) * bf2f(PG[o]);
        mix[(size_t)r * 1024 + c] = f2bf(val);
    }
}

DI void phase_hgscan(int tidx, int bidx, Params& p, float* lds) {
    const int tid = tidx; constexpr int ST = 276, BUF = 32 * ST;
    const bf16_t* U = (const bf16_t*)(p.ws + OFF_U) + 2048; const float* lbv = (const float*)(p.ws + OFF_MISC);
    for (int unit = bidx; unit < 256; unit += gridDim.x) {
        const int vs = unit & 7, scan = unit >> 3; const int d = scan & 1, h = (scan >> 1) & 3, bl = scan >> 3;
        bf16_t* O = (bf16_t*)(p.ws + (d ? OFF_O1 : OFF_O0));
        __syncthreads();
        float S[8];
#pragma unroll
        for (int q = 0; q < 8; ++q) S[q] = 0.f;
        const int ksl = tid & 15, vcol = (tid >> 4) & 15;
        for (int ch = -1; ch < 136; ++ch) {
            if (tid >= 256) {
                if (ch + 1 < 136) {
                    const int i = tid - 256, step = i >> 3, grp = i & 7; float* dst = lds + ((ch + 1) & 1) * BUF + step * ST;
                    const int row = scan_row((ch + 1) * 32 + step, bl, d); const bf16_t* ur = U + (size_t)row * 4608;
                    const u32x4 q0 = *(const u32x4*)(ur + h * 128 + grp * 16), q1 = *(const u32x4*)(ur + h * 128 + grp * 16 + 8);
                    const u32x4 f0 = *(const u32x4*)(ur + 512 + d * 512 + h * 128 + grp * 16), f1 = *(const u32x4*)(ur + 512 + d * 512 + h * 128 + grp * 16 + 8);
                    const unsigned i2 = *(const unsigned*)(ur + 1536 + h * 128 + vs * 16 + grp * 2);
                    float f[8];
                    cvt8(q0, f);
#pragma unroll
                    for (int q = 0; q < 8; ++q) f[q] = f[q] * sigmoidf_(f[q]);
                    *(f32x4*)(dst + grp * 16) = (f32x4){f[0], f[1], f[2], f[3]}; *(f32x4*)(dst + grp * 16 + 4) = (f32x4){f[4], f[5], f[6], f[7]};
                    cvt8(q1, f);
#pragma unroll
                    for (int q = 0; q < 8; ++q) f[q] = f[q] * sigmoidf_(f[q]);
                    *(f32x4*)(dst + grp * 16 + 8) = (f32x4){f[0], f[1], f[2], f[3]}; *(f32x4*)(dst + grp * 16 + 12) = (f32x4){f[4], f[5], f[6], f[7]};
                    const float* lbp = lbv + h * 128 + grp * 16;
                    cvt8(f0, f);
#pragma unroll
                    for (int q = 0; q < 8; ++q) f[q] = lbp[q] + (1.f - lbp[q]) * sigmoidf_(f[q]);
                    *(f32x4*)(dst + 128 + grp * 16) = (f32x4){f[0], f[1], f[2], f[3]}; *(f32x4*)(dst + 128 + grp * 16 + 4) = (f32x4){f[4], f[5], f[6], f[7]};
                    cvt8(f1, f);
#pragma unroll
                    for (int q = 0; q < 8; ++q) f[q] = lbp[8 + q] + (1.f - lbp[8 + q]) * sigmoidf_(f[q]);
                    *(f32x4*)(dst + 128 + grp * 16 + 8) = (f32x4){f[0], f[1], f[2], f[3]}; *(f32x4*)(dst + 128 + grp * 16 + 12) = (f32x4){f[4], f[5], f[6], f[7]};
                    dst[256 + grp * 2] = lo2f(i2); dst[256 + grp * 2 + 1] = hi2f(i2);
                    if (grp == 0) ((int*)dst)[272] = row;
                }
            } else if (ch >= 0) {
                const float* buf = lds + (ch & 1) * BUF;
                for (int s = 0; s < 32; ++s) {
                    const float* bp = buf + s * ST;
                    const f32x4 qa = *(const f32x4*)(bp + ksl * 8), qb = *(const f32x4*)(bp + ksl * 8 + 4), fa = *(const f32x4*)(bp + 128 + ksl * 8), fb = *(const f32x4*)(bp + 128 + ksl * 8 + 4);
                    const float iv = bp[256 + vcol]; const int row = ((const int*)bp)[272];
                    float o = 0.f;
#pragma unroll
                    for (int q = 0; q < 4; ++q) { S[q] = fa[q] * S[q] + (1.f - fa[q]) * iv; o += qa[q] * S[q]; S[4 + q] = fb[q] * S[4 + q] + (1.f - fb[q]) * iv; o += qb[q] * S[4 + q]; }
                    o = dpp_sum16(o);
                    if (ksl == 0) O[(size_t)row * 512 + h * 128 + vs * 16 + vcol] = f2bf(o);
                }
            }
            __syncthreads();
        }
    }
}

DI void phase_hgread(int tidx, int bidx, Params& p, int half) {
    const int wid = tidx >> 6, lane = tidx & 63; const bf16_t* U = (const bf16_t*)(p.ws + OFF_U) + 2048;
    const bf16_t* O0 = (const bf16_t*)(p.ws + OFF_O0); const bf16_t* O1 = (const bf16_t*)(p.ws + OFF_O1); bf16_t* mix = (bf16_t*)(p.ws + OFF_ABF) + (size_t)half * MH * 1024;
    const float g0 = p.hg_norm_g[2 * lane], g1 = p.hg_norm_g[2 * lane + 1];
    for (int it = bidx * 8 + wid; it < MH * 4; it += gridDim.x * 8) {
        const int r = it >> 2, h = it & 3; const size_t o = (size_t)r * 512 + h * 128 + 2 * lane;
        const unsigned a = *(const unsigned*)(O0 + o), b = *(const unsigned*)(O1 + o), gw = *(const unsigned*)(U + (size_t)r * 4608 + 2048 + h * 128 + 2 * lane);
        const float x0 = lo2f(a) + lo2f(b), x1 = hi2f(a) + hi2f(b); const float ss = wave_sum(x0 * x0 + x1 * x1); const float rs = rsqrtf(ss * (1.f / 128.f) + 1e-5f);
        const float ga = lo2f(gw), gb = hi2f(gw);
        *(unsigned*)(mix + (size_t)r * 1024 + 512 + h * 128 + 2 * lane) = cvt_pk_bf16(x0 * rs * g0 * ga * sigmoidf_(ga), x1 * rs * g1 * gb * sigmoidf_(gb));
    }
}

DI int attn_row(int b, int s) {
    const int hb = b >> 2, bl = b & 3; return s < 256 ? hb * MH + 16384 + bl * 256 + s : hb * MH + bl * 4096 + (s - 256);
}
DI void phase_attnprep(int tidx, int bidx, Params& p, bf16_t* lds) {
    const int tid = tidx, wid = tid >> 6, lane = tid & 63; bf16_t* U = (bf16_t*)(p.ws + OFF_U3); const float* rope = (const float*)(p.ws + OFF_ROPE);
    bf16_t* VT = (bf16_t*)(p.ws + OFF_VT);
    for (int unit = bidx; unit < 8 * 68 * 8; unit += gridDim.x) {
        const int h = unit & 7, st = (unit >> 3) % 68, b = unit / (68 * 8); const int s0 = st * 64; const int row0 = attn_row(b, s0);
        __syncthreads();
#pragma unroll
        for (int q = 0; q < 2; ++q) { const int i = tid + q * 512, tok = i >> 4, seg = i & 15;
            const u32x4 v = *(const u32x4*)(U + (size_t)(row0 + tok) * 3072 + 2048 + h * 128 + seg * 8);
            unsigned* d = (unsigned*)(lds + tok * 136 + seg * 8); d[0] = v.x; d[1] = v.y; d[2] = v.z; d[3] = v.w; }
        __syncthreads();
#pragma unroll
        for (int q = 0; q < 2; ++q) { const int i = tid + q * 512, e = i >> 3, seg = i & 7; const bf16_t* l = lds + (seg * 8) * 136 + e;
            u32x4 w; w.x = (unsigned)l[0] | ((unsigned)l[136] << 16); w.y = (unsigned)l[272] | ((unsigned)l[408] << 16); w.z = (unsigned)l[544] | ((unsigned)l[680] << 16); w.w = (unsigned)l[816] | ((unsigned)l[952] << 16);
            *(u32x4*)(VT + ((size_t)(b * 8 + h) * 128 + e) * 4352 + s0 + seg * 8) = w; }
    }
    __syncthreads();
    for (int lr = bidx * 8 + wid; lr < NLAT; lr += gridDim.x * 8) {
        const int b = lr >> 12, t = lr & 4095; bf16_t* ur = U + (size_t)attn_row(b, 256 + t) * 3072; const float* rp = rope + t * 64;
#pragma unroll 4
        for (int q = 0; q < 16; ++q) { const int pi = q * 64 + lane; const int vec = pi >> 5, pp = pi & 31; const int hs = pp >> 4, f = pp & 15;
            const int col = vec * 64 + hs * 32 + f; const float cs = rp[hs * 16 + f], sn = rp[32 + hs * 16 + f];
            const float x0 = bf2f(ur[col]), x1 = bf2f(ur[col + 16]); const float sc = vec < 16 ? QSCALE : 1.f;
            ur[col] = f2bf((x0 * cs - x1 * sn) * sc); ur[col + 16] = f2bf((x1 * cs + x0 * sn) * sc); }
    }
}

#define MFMA32(a, b, c) __builtin_amdgcn_mfma_f32_32x32x16_bf16((a), (b), (c), 0, 0, 0)
DI void phase_attn(int tidx, int bidx, Params& p, char* ldsb) {
    const int tid = tidx, wid = tid >> 6, lane = tid & 63, l31 = lane & 31, hf = lane >> 5; const int m = wid & 1, qsub = wid >> 1;
    const bf16_t* U = (const bf16_t*)(p.ws + OFF_U3); const bf16_t* VT = (const bf16_t*)(p.ws + OFF_VT); bf16_t* mix = (bf16_t*)(p.ws + OFF_ABF);
    const float lam = ((const float*)(p.ws + OFF_MISC))[512];
    constexpr int KB = 2 * 64 * 144, VB = 128 * 144, TB = KB + VB;
    for (int item = bidx; item < 2048; item += gridDim.x) {
        const int qb = item & 31, h = (item >> 5) & 7, b = item >> 8;
        const int qrow = attn_row(b, 256 + qb * 128 + qsub * 32 + l31);
        bf16x8 qf[4];
#pragma unroll
        for (int dc = 0; dc < 4; ++dc) qf[dc] = *(const bf16x8*)(U + (size_t)qrow * 3072 + h * 128 + m * 64 + dc * 16 + hf * 8);
        f32x16 o[4];
#pragma unroll
        for (int v = 0; v < 4; ++v)
#pragma unroll
            for (int r = 0; r < 16; ++r) o[v][r] = 0.f;
        float mrun = -INFINITY, lsum = 0.f;
        u32x4 kreg[2], vreg[2];
        const bf16_t* vtb = VT + (size_t)(b * 8 + h) * 128 * 4352;
#define ATT_LOAD(j) do { _Pragma("unroll") for (int q = 0; q < 2; ++q) { const int i = tid + q * 512; \
            kreg[q] = *(const u32x4*)(U + (size_t)attn_row(b, (j) * 64 + (i >> 4)) * 3072 + 1024 + h * 128 + (i & 15) * 8); \
            vreg[q] = *(const u32x4*)(vtb + (size_t)(i >> 3) * 4352 + (j) * 64 + (i & 7) * 8); } } while (0)
#define ATT_STORE(bufi) do { char* base = ldsb + (bufi) * TB; _Pragma("unroll") for (int q = 0; q < 2; ++q) { const int i = tid + q * 512; const int seg = i & 15; \
            *(u32x4*)(base + ((seg >> 3) * 64 + (i >> 4)) * 144 + (seg & 7) * 16) = kreg[q]; \
            *(u32x4*)(base + KB + (i >> 3) * 144 + (i & 7) * 16) = vreg[q]; } } while (0)
        __syncthreads();
        ATT_LOAD(0); ATT_STORE(0);
        __syncthreads();
        for (int j = 0; j < 68; ++j) {
            if (j + 1 < 68) ATT_LOAD(j + 1);
            const char* kb = ldsb + (j & 1) * TB + m * (64 * 144); const char* vb = ldsb + (j & 1) * TB + KB;
            f32x16 s[2];
#pragma unroll
            for (int k2 = 0; k2 < 2; ++k2) {
#pragma unroll
                for (int r = 0; r < 16; ++r) s[k2][r] = 0.f;
#pragma unroll
                for (int dc = 0; dc < 4; ++dc) { const bf16x8 a = *(const bf16x8*)(kb + (k2 * 32 + l31) * 144 + dc * 32 + hf * 16); s[k2] = MFMA32(a, qf[dc], s[k2]); }
            }
            float mx = -INFINITY;
#pragma unroll
            for (int k2 = 0; k2 < 2; ++k2)
#pragma unroll
                for (int r = 0; r < 16; ++r) mx = fmaxf(mx, s[k2][r]);
            mx = fmaxf(mx, __shfl_xor(mx, 32, 64));
            const float mnew = fmaxf(mrun, mx); const float alpha = __builtin_amdgcn_exp2f(mrun - mnew); mrun = mnew;
            float ps = 0.f;
#pragma unroll
            for (int k2 = 0; k2 < 2; ++k2)
#pragma unroll
                for (int r = 0; r < 16; ++r) { const float e = __builtin_amdgcn_exp2f(s[k2][r] - mnew); s[k2][r] = e; ps += e; }
            lsum = lsum * alpha + ps;
#pragma unroll
            for (int v = 0; v < 4; ++v)
#pragma unroll
                for (int r = 0; r < 16; ++r) o[v][r] *= alpha;
#pragma unroll
            for (int k2 = 0; k2 < 2; ++k2)
#pragma unroll
                for (int st = 0; st < 2; ++st) {
                    u32x4 pw; pw.x = cvt_pk_bf16(s[k2][8 * st], s[k2][8 * st + 1]); pw.y = cvt_pk_bf16(s[k2][8 * st + 2], s[k2][8 * st + 3]);
                    pw.z = cvt_pk_bf16(s[k2][8 * st + 4], s[k2][8 * st + 5]); pw.w = cvt_pk_bf16(s[k2][8 * st + 6], s[k2][8 * st + 7]);
                    const bf16x8 pf = __builtin_bit_cast(bf16x8, pw);
#pragma unroll
                    for (int v = 0; v < 4; ++v) { const char* va = vb + (v * 32 + l31) * 144 + (k2 * 32 + st * 16 + hf * 4) * 2;
                        const u32x2 lo = *(const u32x2*)va, hi = *(const u32x2*)(va + 16); u32x4 aw; aw.x = lo.x; aw.y = lo.y; aw.z = hi.x; aw.w = hi.y;
                        o[v] = MFMA32(__builtin_bit_cast(bf16x8, aw), pf, o[v]); }
                }
            if (j + 1 < 68) ATT_STORE((j + 1) & 1);
            __syncthreads();
        }
        const float linv = 1.f / (lsum + __shfl_xor(lsum, 32, 64));
        float* ex = (float*)ldsb + (size_t)qsub * 4096;
        if (m == 1) {
#pragma unroll
            for (int v = 0; v < 4; ++v)
#pragma unroll
                for (int r = 0; r < 16; ++r) ex[(v * 16 + r) * 64 + lane] = o[v][r] * linv;
        }
        __syncthreads();
        if (m == 0) {
            float ss = 0.f;
#pragma unroll
            for (int v = 0; v < 4; ++v)
#pragma unroll
                for (int r = 0; r < 16; ++r) { const float x = o[v][r] * linv - lam * ex[(v * 16 + r) * 64 + lane]; o[v][r] = x; ss += x * x; }
            ss += __shfl_xor(ss, 32, 64); const float rs = rsqrtf(ss * (1.f / 128.f) + 1e-5f) * (1.f - LAM_INIT);
            bf16_t* orow = mix + (size_t)qrow * 1024 + h * 128;
#pragma unroll
            for (int v = 0; v < 4; ++v)
#pragma unroll
                for (int g = 0; g < 4; ++g) { const int e = v * 32 + 8 * g + 4 * hf; const f32x4 ng = *(const f32x4*)(p.da_norm_g + e);
                    u32x2 w; w.x = cvt_pk_bf16(o[v][4 * g] * rs * ng[0], o[v][4 * g + 1] * rs * ng[1]); w.y = cvt_pk_bf16(o[v][4 * g + 2] * rs * ng[2], o[v][4 * g + 3] * rs * ng[3]);
                    *(u32x2*)(orow + e) = w; }
        }
    }
}

enum { K_PRE = 0, K_MODFIN, K_MODIN, K_SWIGLU, K_F32, K_BF16, K_POSTNORM, K_RWPREP, K_RWSCAN, K_RWREAD, K_HGSCAN, K_HGREAD, K_ATTNPREP, K_ATTN };
constexpr int NPHASE = 34;
#ifndef ENMASK
#define ENMASK 0xFFFF
#endif
#define EN(k) ((ENMASK >> (k)) & 1)

__global__ __launch_bounds__(512, 2) void mega(ParamsS pv, int ph0, int ph1) {
    extern __shared__ __attribute__((aligned(16))) unsigned char shm[];
    cg::grid_group grid = cg::this_grid();
    for (int ph = ph0; ph < ph1; ++ph) {
        const __attribute__((address_space(4))) char* ka = (const __attribute__((address_space(4))) char*)__builtin_amdgcn_kernarg_segment_ptr();
        asm volatile("" : "+s"(ka));
        Params& p = *(Params*)ka;
        int tidx = threadIdx.x; asm volatile("" : "+v"(tidx)); int bidx = blockIdx.x; asm volatile("" : "+s"(bidx));
        int kind = 0, layer = 0, j = 0, first = 0, nl = -1, nj = 0, skip = 0, half = 0, widx = 0; float wgt = 0.5f;
        switch (ph) {
            case 0: kind = K_PRE; break;
            case 1: kind = K_MODFIN; break;
            case 2: kind = K_MODIN; break;
            case 3: kind = K_SWIGLU; widx = 0; break;
            case 4: kind = K_F32; widx = 0; break;
            case 5: kind = K_POSTNORM; layer = 0; j = 0; first = 1; nl = 0; nj = 1; break;
            case 6: kind = K_BF16; widx = 0; half = 0; break;
            case 7: kind = K_RWPREP; break;
            case 8: kind = K_RWSCAN; break;
            case 9: kind = K_RWREAD; half = 0; break;
            case 10: kind = K_HGSCAN; break;
            case 11: kind = K_HGREAD; half = 0; break;
            case 12: kind = K_BF16; widx = 0; half = 1; break;
            case 13: kind = K_RWPREP; break;
            case 14: kind = K_RWSCAN; break;
            case 15: kind = K_RWREAD; half = 1; break;
            case 16: kind = K_HGSCAN; break;
            case 17: kind = K_HGREAD; half = 1; break;
            case 18: kind = K_F32; widx = 4; break;
            case 19: kind = K_POSTNORM; layer = 0; j = 1; wgt = 1.f; nl = 0; nj = 2; break;
            case 20: kind = K_SWIGLU; widx = 1; break;
            case 21: kind = K_F32; widx = 1; break;
            case 22: kind = K_POSTNORM; layer = 0; j = 2; nl = 1; nj = 0; break;
            case 23: kind = K_SWIGLU; widx = 2; break;
            case 24: kind = K_F32; widx = 2; break;
            case 25: kind = K_POSTNORM; layer = 1; j = 0; nl = 1; nj = 1; break;
            case 26: kind = K_BF16; widx = 1; break;
            case 27: kind = K_ATTNPREP; break;
            case 28: kind = K_ATTN; break;
            case 29: kind = K_F32; widx = 5; skip = 1; break;
            case 30: kind = K_POSTNORM; layer = 1; j = 1; wgt = 1.f; nl = 1; nj = 2; skip = 1; break;
            case 31: kind = K_SWIGLU; widx = 3; skip = 1; break;
            case 32: kind = K_F32; widx = 3; skip = 1; break;
            default: kind = K_POSTNORM; layer = 1; j = 2; nl = -1; skip = 1; break;
        }
        if (EN(K_SWIGLU) && kind == K_SWIGLU) {
            Gemm g; g.A = (const bf16_t*)(p.ws + OFF_ABF); g.Bt = (const bf16_t*)(p.ws + OFF_WFI + widx * SZ_WFI); g.M = skip ? NLAT : MROWS; g.N = 5632; g.K = 1024;
            Order S; S.init(g.M, g.N, (int)gridDim.x, bidx, skip); EpiSwiglu E; E.O = (bf16_t*)(p.ws + OFF_HID); E.ldc = FF;
            pg8::gemm_phase<EpiSwiglu, Order, false>(tidx, (PG8_LAS unsigned char*)shm, g, S, E, nullptr);
        } else if (EN(K_F32) && kind == K_F32) {
            Gemm g; g.M = skip ? NLAT : MROWS; g.N = 1024;
            if (widx < 4) { g.A = (const bf16_t*)(p.ws + OFF_HID); g.Bt = (const bf16_t*)(p.ws + OFF_WFO + widx * SZ_WFO); g.K = FF; }
            else { g.A = (const bf16_t*)(p.ws + OFF_ABF); g.Bt = (const bf16_t*)(p.ws + (widx == 4 ? OFF_WEO : OFF_WOO)); g.K = 1024; }
            Order S; S.init(g.M, g.N, (int)gridDim.x, bidx, skip); pg8::EpiF32 E; E.C = (float*)(p.ws + OFF_OUTF); E.ldc = 1024; E.bias = nullptr;
            pg8::gemm_phase<pg8::EpiF32, Order, false>(tidx, (PG8_LAS unsigned char*)shm, g, S, E, nullptr);
        } else if (EN(K_BF16) && kind == K_BF16) {
            Gemm g; pg8::EpiBf16<0> E; E.bias = nullptr; E.split_cols = 0; E.split_stride = 0; g.K = 1024;
            if (widx == 0) { g.A = (const bf16_t*)(p.ws + OFF_ABF) + (size_t)half * MH * 1024; g.Bt = (const bf16_t*)(p.ws + OFF_WEI); g.M = MH; g.N = 4608; E.O = (bf16_t*)(p.ws + OFF_U); E.ldc = 4608; }
            else { g.A = (const bf16_t*)(p.ws + OFF_ABF); g.Bt = (const bf16_t*)(p.ws + OFF_WOI); g.M = MROWS; g.N = 3072; E.O = (bf16_t*)(p.ws + OFF_U3); E.ldc = 3072; }
            Order S; S.init(g.M, g.N, (int)gridDim.x, bidx, 0);
            pg8::gemm_phase<pg8::EpiBf16<0>, Order, false>(tidx, (PG8_LAS unsigned char*)shm, g, S, E, nullptr);
        }
        else if (EN(K_PRE) && kind == K_PRE) phase_pre(tidx, bidx, p, (float*)shm);
        else if (EN(K_MODFIN) && kind == K_MODFIN) phase_modfin(tidx, bidx, p);
        else if (EN(K_MODIN) && kind == K_MODIN) phase_modin(tidx, bidx, p);
        else if (EN(K_POSTNORM) && kind == K_POSTNORM) phase_postnorm(tidx, bidx, p, layer, j, wgt, first, nl, nj, skip);
        else if (EN(K_RWPREP) && kind == K_RWPREP) phase_rwprep(tidx, bidx, p, (float*)shm);
        else if (EN(K_RWSCAN) && kind == K_RWSCAN) phase_rwscan(tidx, bidx, p, (float*)shm);
        else if (EN(K_RWREAD) && kind == K_RWREAD) phase_rwread(tidx, bidx, p, half);
        else if (EN(K_HGSCAN) && kind == K_HGSCAN) phase_hgscan(tidx, bidx, p, (float*)shm);
        else if (EN(K_HGREAD) && kind == K_HGREAD) phase_hgread(tidx, bidx, p, half);
        else if (EN(K_ATTNPREP) && kind == K_ATTNPREP) phase_attnprep(tidx, bidx, p, (bf16_t*)shm);
        else if (EN(K_ATTN)) phase_attn(tidx, bidx, p, (char*)shm);
        if (ph + 1 < ph1) grid.sync();
    }
}

extern "C" void kernel_launch(void* const* d_in, const int* in_sizes, int n_in, void* d_out, int out_size, void* d_ws, size_t ws_size, hipStream_t stream) {
    static int grid_blocks = 0;
    if (!grid_blocks) {
        hipFuncSetAttribute((const void*)mega, hipFuncAttributeMaxDynamicSharedMemorySize, LDS_BYTES);
        int dev = 0, cus = 0, per_cu = 0; hipGetDevice(&dev); hipDeviceGetAttribute(&cus, hipDeviceAttributeMultiprocessorCount, dev);
        hipOccupancyMaxActiveBlocksPerMultiprocessor(&per_cu, mega, 512, LDS_BYTES);
        if (per_cu < 1) per_cu = 1;
        grid_blocks = cus * 1;
        if (ws_size < WS_NEED) fprintf(stderr, "workspace too small: %zu < %zu\n", ws_size, (size_t)WS_NEED);
    }
    ParamsS p{};
    const float** f = (const float**)&p;
    for (int i = 0; i < 29; ++i) f[i] = (const float*)d_in[i];
    p.out = (float*)d_out; p.ws = (char*)d_ws;
#if COOP
    int ph0 = 0, ph1 = NPHASE; void* args[] = {&p, &ph0, &ph1};
    hipError_t e = hipLaunchCooperativeKernel((const void*)mega, dim3(grid_blocks), dim3(512), args, LDS_BYTES, stream);
    if (e != hipSuccess) fprintf(stderr, "cooperative launch failed: %s (grid %d)\n", hipGetErrorString(e), grid_blocks);
#else
    for (int ph = 0; ph < NPHASE; ++ph) mega<<<grid_blocks, 512, LDS_BYTES, stream>>>(p, ph, ph + 1);
#endif
}
```

```cpp
#include <hip/hip_runtime.h>
#include <hip/hip_cooperative_groups.h>
#include <hip/hip_fp16.h>
#include <cstdio>
namespace cg = cooperative_groups;
#ifndef COOP
#define COOP 1
#endif
#define DI __device__ __forceinline__
namespace pg8 {
#define PG8_LAS __attribute__((address_space(3)))
typedef unsigned short bf16_t;
typedef short bf16x8 __attribute__((ext_vector_type(8)));
typedef float f32x4 __attribute__((ext_vector_type(4)));
typedef unsigned u32x4 __attribute__((ext_vector_type(4)));
constexpr int BM = 256, BK = 64, HALF = 128, HTB = HALF * BK * 2  , STAGE_BYTES = 8 * HTB, NXCD = 8, WGM = 8;

__host__ __device__ __forceinline__ int lds_byte(int r, int c) { const int st = (r >> 4) * 2 + (c >> 5), rr = r & 15, cc = c & 31, ob = rr * 64 + cc * 2; return st * 1024 + (ob ^ (((ob >> 9) & 1) << 5)); }
__host__ __device__ __forceinline__ void stage_rc(int b, int& R, int& C) { const int st = b / 1024, sb = b % 1024, swz = sb ^ (((sb >> 9) & 1) << 5); R = (st >> 1) * 16 + swz / 64; C = (st & 1) * 32 + (swz % 64) / 2; }
__host__ __device__ __forceinline__ int perm32(int rho) { const int n = rho >> 4, i = rho & 15; return 8 * (i >> 2) + 4 * n + (i & 3); }

struct Unit { int pm, pn; };
struct Gemm { const bf16_t* A; const bf16_t* Bt; int M, N, K; };

__device__ __forceinline__ unsigned cvt_pk_bf16(float lo, float hi) { unsigned r; asm volatile("v_cvt_pk_bf16_f32 %0, %1, %2" : "=v"(r) : "v"(lo), "v"(hi)); return r; }
typedef float f32x2 __attribute__((ext_vector_type(2)));
__device__ __forceinline__ f32x2 gelu_pk(f32x2 v) {
    const f32x2 av = __builtin_elementwise_abs(v), d = av * 0.2316418882f + 1.0f;
    f32x2 t; t.x = __builtin_amdgcn_rcpf(d.x); t.y = __builtin_amdgcn_rcpf(d.y);
    f32x2 q = t * 0.5307027145f + (-0.7265760135f); q = q * t + 0.7107068705f; q = q * t + (-0.142248368f); q = q * t + 0.127414796f; q = q * t;
    const f32x2 s = (v * v) * (-0.72134752044f);
    f32x2 e; e.x = __builtin_amdgcn_exp2f(s.x); e.y = __builtin_amdgcn_exp2f(s.y);
    const f32x2 m = v * (q * e), r = v - m;
    f32x2 o; o.x = v.x < 0.f ? m.x : r.x; o.y = v.y < 0.f ? m.y : r.y; return o;
}

struct EpiF32 {
    static constexpr bool PERM = false, AFTER_DRAIN = false;
    float* C; int ldc; const float* bias;
    __device__ __forceinline__ void operator()(const f32x4 (&acc)[2][2][4][2], const Unit& u, int wr, int wc, int fr, int fq) const {
        const int row0 = u.pm * BM + wr * 64 + fr, col0 = u.pn * BM + wc * 32 + 4 * fq;
        f32x4 bv[2][2];
#pragma unroll
        for (int bj = 0; bj < 2; ++bj)
#pragma unroll
            for (int n = 0; n < 2; ++n) bv[bj][n] = bias ? *(const f32x4*)(bias + col0 + bj * HALF + n * 16) : (f32x4){0.f, 0.f, 0.f, 0.f};
#pragma unroll
        for (int ai = 0; ai < 2; ++ai)
#pragma unroll
            for (int m = 0; m < 4; ++m) { float* rowp = C + (size_t)(row0 + ai * HALF + m * 16) * ldc + col0;
#pragma unroll
                for (int bj = 0; bj < 2; ++bj)
#pragma unroll
                    for (int n = 0; n < 2; ++n) *(f32x4*)(rowp + bj * HALF + n * 16) = acc[ai][bj][m][n] + bv[bj][n]; }
    }
};
template <int ACT  > struct EpiBf16 {
    static constexpr bool PERM = true, AFTER_DRAIN = false;
    bf16_t* O; int ldc; const float* bias; int split_cols; size_t split_stride;
    __device__ __forceinline__ void operator()(const f32x4 (&acc)[2][2][4][2], const Unit& u, int wr, int wc, int fr, int fq) const {
        const int row0 = u.pm * BM + wr * 64 + fr; int colt = u.pn * BM; bf16_t* base = O;
        if (split_cols) { const int t = colt / split_cols; base += (size_t)t * split_stride; colt -= t * split_cols; }
        const int col0 = colt + wc * 32 + 8 * fq, bcol0 = u.pn * BM + wc * 32 + 8 * fq;
        f32x4 bv[2][2];
#pragma unroll
        for (int bj = 0; bj < 2; ++bj)
#pragma unroll
            for (int n = 0; n < 2; ++n) bv[bj][n] = bias ? *(const f32x4*)(bias + bcol0 + bj * HALF + 4 * n) : (f32x4){0.f, 0.f, 0.f, 0.f};
#pragma unroll
        for (int ai = 0; ai < 2; ++ai)
#pragma unroll
            for (int m = 0; m < 4; ++m) { bf16_t* rowp = base + (size_t)(row0 + ai * HALF + m * 16) * ldc + col0;
#pragma unroll
                for (int bj = 0; bj < 2; ++bj) { f32x4 v0 = acc[ai][bj][m][0] + bv[bj][0], v1 = acc[ai][bj][m][1] + bv[bj][1];
                    if (ACT == 1) { f32x2 a = gelu_pk((f32x2){v0[0], v0[1]}), b = gelu_pk((f32x2){v0[2], v0[3]}), c = gelu_pk((f32x2){v1[0], v1[1]}), d = gelu_pk((f32x2){v1[2], v1[3]});
                        v0 = (f32x4){a.x, a.y, b.x, b.y}; v1 = (f32x4){c.x, c.y, d.x, d.y}; }
                    if (ACT == 2) {
#pragma unroll
                        for (int j = 0; j < 4; ++j) { v0[j] = 0.5f * v0[j] * (1.0f + erff(v0[j] * 0.70710678f)); v1[j] = 0.5f * v1[j] * (1.0f + erff(v1[j] * 0.70710678f)); } }
                    u32x4 w; w.x = cvt_pk_bf16(v0[0], v0[1]); w.y = cvt_pk_bf16(v0[2], v0[3]); w.z = cvt_pk_bf16(v1[0], v1[1]); w.w = cvt_pk_bf16(v1[2], v1[3]);
                    *(u32x4*)(rowp + bj * HALF) = w; } }
    }
};

template <class Epi, class Sched, bool STAMP = false>
__device__ __forceinline__ void gemm_phase(int tidx, PG8_LAS unsigned char* lds, const Gemm g, const Sched& S, const Epi& E, unsigned long long* stamps) {
    const int tid = tidx, wid = __builtin_amdgcn_readfirstlane(tid >> 6), lane = tid & 63, wr = wid >> 2, wc = wid & 3, fr = lane & 15, fq = lane >> 4;
    const int K = g.K, nt = K / BK;
    int ts_lo = 0, ts_hi = 0, nts = 0; const unsigned long long rt_entry = STAMP ? (unsigned long long)wall_clock64() : 0ull;
#define PG8_STAMP() do { if (STAMP && wid == 0 && nts < 64) { const unsigned long long _c = (unsigned long long)clock64(); \
        ts_lo = (lane == nts) ? (int)(unsigned)_c : ts_lo; ts_hi = (lane == nts) ? (int)(unsigned)(_c >> 32) : ts_hi; ++nts; } } while (0)
    PG8_STAMP();
    unsigned voffA[2], voffB[2];
#pragma unroll
    for (int i = 0; i < 2; ++i) { int R, C; stage_rc(tid * 16 + i * 8192, R, C); const int Rb = Epi::PERM ? ((R & ~31) + perm32(R & 31)) : R;
        voffA[i] = (unsigned)(R * K + C) * 2u; voffB[i] = (unsigned)(Rb * K + C) * 2u; }
    const size_t kstep = (size_t)(BK * 2);
    const size_t hstep = (size_t)HALF * K * 2;
    const size_t tstep = 2 * hstep;
    const unsigned ldsw = (unsigned)wid * 1024u;
    const int aoff = lds_byte(wr * 64 + fr, fq * 8), boff = lds_byte(wc * 32 + fr, fq * 8);
#define PG8_SA(b, h) (((b) * 2 + (h)) * HTB)
#define PG8_SB(b, h) ((4 + (b) * 2 + (h)) * HTB)
#define PG8_STAGE(bufoff, gbase, voff) do { _Pragma("unroll") for (int _i = 0; _i < 2; ++_i) \
        __builtin_amdgcn_global_load_lds((const unsigned*)((const char*)(gbase) + (voff)[_i]), (PG8_LAS unsigned*)(lds + (bufoff) + ldsw + _i * 8192), 16, 0, 0); } while (0)
#define PG8_LDA(dst, b, h) do { _Pragma("unroll") for (int m = 0; m < 4; ++m) _Pragma("unroll") for (int k = 0; k < 2; ++k) dst[m][k] = *(const PG8_LAS bf16x8*)(lds + PG8_SA(b, h) + aoff + m * 2048 + k * 1024); } while (0)
#define PG8_LDB(dst, b, h) do { _Pragma("unroll") for (int n = 0; n < 2; ++n) _Pragma("unroll") for (int k = 0; k < 2; ++k) dst[n][k] = *(const PG8_LAS bf16x8*)(lds + PG8_SB(b, h) + boff + n * 2048 + k * 1024); } while (0)
#define PG8_MMA(ai, bj, At, Bt) do { __builtin_amdgcn_s_setprio(1); _Pragma("unroll") for (int m = 0; m < 4; ++m) _Pragma("unroll") for (int n = 0; n < 2; ++n) _Pragma("unroll") for (int k = 0; k < 2; ++k) \
        acc[ai][bj][m][n] = __builtin_amdgcn_mfma_f32_16x16x32_bf16(Bt[n][k], At[m][k], acc[ai][bj][m][n], 0, 0, 0); __builtin_amdgcn_s_setprio(0); } while (0)
#define PG8_WAIT_V(n) asm volatile("s_waitcnt vmcnt(" #n ")" ::: "memory")
#define PG8_WAIT_L(n) asm volatile("s_waitcnt lgkmcnt(" #n ")" ::: "memory")
#define PG8_BAR __builtin_amdgcn_s_barrier()
#define PG8_SCHED __builtin_amdgcn_sched_barrier(0)
    Unit cur, nxt; int ui = 0;
    if (!S.next(0, cur)) return;
    f32x4 acc[2][2][4][2];
#pragma unroll
    for (int a = 0; a < 2; ++a)
#pragma unroll
        for (int b = 0; b < 2; ++b)
#pragma unroll
            for (int m = 0; m < 4; ++m)
#pragma unroll
                for (int n = 0; n < 2; ++n) acc[a][b][m][n] = (f32x4){0.f, 0.f, 0.f, 0.f};
    bf16x8 At[4][2], B0[2][2], B1[2][2];
    const char* cA = (const char*)g.A + (size_t)cur.pm * tstep; const char* cB = (const char*)g.Bt + (size_t)cur.pn * tstep;
    S.a_ready(cur);
    PG8_STAGE(PG8_SB(0, 0), cB, voffB); PG8_STAGE(PG8_SA(0, 0), cA, voffA); PG8_STAGE(PG8_SB(0, 1), cB + hstep, voffB); PG8_STAGE(PG8_SA(0, 1), cA + hstep, voffA);
    if (wr == 1) PG8_BAR;
    PG8_WAIT_V(4); PG8_BAR;
    PG8_STAGE(PG8_SB(1, 0), cB + kstep, voffB); PG8_STAGE(PG8_SA(1, 0), cA + kstep, voffA); PG8_STAGE(PG8_SB(1, 1), cB + hstep + kstep, voffB);
    PG8_WAIT_V(6); PG8_BAR;
    PG8_STAMP();
    for (;;) {
        const bool has_next = S.next(ui + 1, nxt);
        const char* nA = has_next ? (const char*)g.A + (size_t)nxt.pm * tstep : cA; const char* nB = has_next ? (const char*)g.Bt + (size_t)nxt.pn * tstep : cB;
        for (int t = 0; t < nt; t += 2) {
            const bool last = (t == nt - 2);
            const char* a1 = cA + (size_t)(t + 1) * kstep;
            const char* a2 = last ? nA : cA + (size_t)(t + 2) * kstep; const char* b2 = last ? nB : cB + (size_t)(t + 2) * kstep;
            const char* a3 = a2 + kstep; const char* b3 = b2 + kstep;
            if (last && has_next) S.a_ready(nxt);
            PG8_LDB(B0, 0, 0); PG8_SCHED; PG8_LDA(At, 0, 0); PG8_STAGE(PG8_SA(1, 1), a1 + hstep, voffA);
            PG8_WAIT_L(8); PG8_BAR; PG8_WAIT_L(0); PG8_MMA(0, 0, At, B0); PG8_BAR; PG8_SCHED;
            PG8_LDB(B1, 0, 1); PG8_STAGE(PG8_SB(0, 0), b2, voffB);
            PG8_BAR; PG8_WAIT_L(0); PG8_MMA(0, 1, At, B1); PG8_BAR;
            PG8_LDA(At, 0, 1); PG8_STAGE(PG8_SA(0, 0), a2, voffA);
            PG8_BAR; PG8_WAIT_L(0); PG8_MMA(1, 0, At, B0); PG8_BAR; PG8_SCHED;
            PG8_STAGE(PG8_SB(0, 1), b2 + hstep, voffB);
            PG8_WAIT_V(6); PG8_BAR; PG8_MMA(1, 1, At, B1); PG8_BAR;
            PG8_LDB(B0, 1, 0); PG8_SCHED; PG8_LDA(At, 1, 0); PG8_STAGE(PG8_SA(0, 1), a2 + hstep, voffA);
            PG8_WAIT_L(8); PG8_BAR; PG8_WAIT_L(0); PG8_MMA(0, 0, At, B0); PG8_BAR; PG8_SCHED;
            PG8_LDB(B1, 1, 1); PG8_STAGE(PG8_SB(1, 0), b3, voffB);
            PG8_BAR; PG8_WAIT_L(0); PG8_MMA(0, 1, At, B1); PG8_BAR;
            PG8_LDA(At, 1, 1); PG8_STAGE(PG8_SA(1, 0), a3, voffA);
            PG8_BAR; PG8_WAIT_L(0); PG8_MMA(1, 0, At, B0); PG8_BAR; PG8_SCHED;
            PG8_STAGE(PG8_SB(1, 1), b3 + hstep, voffB);
            PG8_WAIT_V(6); PG8_BAR; PG8_MMA(1, 1, At, B1); PG8_BAR;
        }
        PG8_STAMP();
        if constexpr (!Epi::AFTER_DRAIN) { E(acc, cur, wr, wc, fr, fq); S.done(cur); }
        PG8_STAMP();
        if (!has_next) break;
#pragma unroll
        for (int a = 0; a < 2; ++a)
#pragma unroll
            for (int b = 0; b < 2; ++b)
#pragma unroll
                for (int m = 0; m < 4; ++m)
#pragma unroll
                    for (int n = 0; n < 2; ++n) acc[a][b][m][n] = (f32x4){0.f, 0.f, 0.f, 0.f};
        cur = nxt; cA = nA; cB = nB; ++ui;
    }
    PG8_WAIT_V(0);
    if (wr == 0) PG8_BAR;
    PG8_BAR;
    if constexpr (Epi::AFTER_DRAIN) { E.fused(acc, cur, wr, wc, fr, fq, lds, wid, lane); S.done(cur); }
    PG8_STAMP();
    if (STAMP && wid == 0) { stamps[lane] = lane < nts ? (((unsigned long long)(unsigned)ts_hi << 32) | (unsigned)ts_lo) : 0ull;
        if (lane == 62) stamps[62] = rt_entry; if (lane == 63) stamps[63] = (unsigned long long)wall_clock64(); }
#undef PG8_STAMP
#undef PG8_SA
#undef PG8_SB
#undef PG8_STAGE
#undef PG8_LDA
#undef PG8_LDB
#undef PG8_MMA
#undef PG8_WAIT_V
#undef PG8_WAIT_L
#undef PG8_BAR
#undef PG8_SCHED
}
}

#define XB_TMO      128
#define XB_XCNT(j)  (256  + 64 * (j))
#define XB_XSUB(j)  (1280 + 64 * (j))
#define XB_XGEN(j)  (2304 + 64 * (j))
#define XB_TOP      3328
#define XB_TOPGEN   3392
#define XCD_BAR_WORDS 3456
#define XB_SPIN_CAP (1u << 22)
#define LAS __attribute__((address_space(3)))

__device__ __forceinline__ unsigned xb_ld(unsigned* p)              { return __hip_atomic_load(p, __ATOMIC_RELAXED, __HIP_MEMORY_SCOPE_AGENT); }
__device__ __forceinline__ unsigned xb_add(unsigned* p, unsigned v) { return __hip_atomic_fetch_add(p, v, __ATOMIC_RELAXED, __HIP_MEMORY_SCOPE_AGENT); }
__device__ __forceinline__ unsigned xb_xcc_id() { return (unsigned)__builtin_amdgcn_s_getreg((3 << 11) | 20) & 0xFu; }
#define XB_SPIN(cond, bar) do { unsigned _sp = 0; while (cond) { __builtin_amdgcn_s_sleep(1); \
    if ((++_sp & 255u) == 0u) { if (xb_ld(&(bar)[XB_TMO])) break; if (_sp > XB_SPIN_CAP) { atomicAdd(&(bar)[XB_TMO], 1u); break; } } } } while (0)

struct XcdBarrier {
    unsigned* bar; unsigned x;
    volatile LAS unsigned* st;
};

__device__ __forceinline__ XcdBarrier xcd_barrier_post(unsigned* bar, volatile LAS unsigned* st) {
    XcdBarrier b; b.bar = bar; b.x = xb_xcc_id(); b.st = st;
    if (threadIdx.x == 0) (void)xb_add(&bar[XB_XCNT(b.x)], 1u);
    return b;
}
__device__ __forceinline__ void xcd_barrier_complete(unsigned* bar, unsigned x, unsigned& nloc, unsigned& nx) {
    const unsigned G = gridDim.x * gridDim.y * gridDim.z;
    unsigned sum, cnt, mine, sp = 0u;
    for (;;) {
        sum = 0u; cnt = 0u; mine = 0u;
#pragma unroll
        for (unsigned j = 0; j < 16; ++j) { const unsigned c = xb_ld(&bar[XB_XCNT(j)]); sum += c; cnt += (c > 0u) ? 1u : 0u; mine = (j == x) ? c : mine; }
        if (sum == G) break;
        __builtin_amdgcn_s_sleep(1);
        if ((++sp & 255u) == 0u) { if (xb_ld(&bar[XB_TMO])) break; if (sp > XB_SPIN_CAP) { atomicAdd(&bar[XB_TMO], 1u); break; } }
    }
    nloc = mine > 0u ? mine : 1u; nx = cnt > 0u ? cnt : 1u;
}

__device__ __forceinline__ void xcd_barrier(const XcdBarrier& b) {
    asm volatile("s_waitcnt vmcnt(0)" ::: "memory");
    __syncthreads();
    if (threadIdx.x == 0) {
        unsigned* bar = b.bar;
        __builtin_amdgcn_s_waitcnt(0);
        unsigned nloc = b.st[0], nx = b.st[1];
        if (nloc == 0u) { xcd_barrier_complete(bar, b.x, nloc, nx); b.st[0] = nloc; b.st[1] = nx; }
        const unsigned old = xb_add(&bar[XB_XSUB(b.x)], 1u);
        const unsigned gen = old / nloc;
        if (old + 1u == (gen + 1u) * nloc) {
            __builtin_amdgcn_fence(__ATOMIC_RELEASE, "agent");
            asm volatile("s_waitcnt vmcnt(0)" ::: "memory");
            const unsigned og = xb_add(&bar[XB_TOP], 1u);
            const unsigned tg = og / nx;
            if (og + 1u == (tg + 1u) * nx) xb_add(&bar[XB_TOPGEN], 1u);
            else XB_SPIN(xb_ld(&bar[XB_TOPGEN]) == tg, bar);
            __builtin_amdgcn_fence(__ATOMIC_ACQUIRE, "agent");
            xb_add(&bar[XB_XGEN(b.x)], 1u);
            asm volatile("s_waitcnt vmcnt(0)" ::: "memory");
        } else {
            XB_SPIN(xb_ld(&bar[XB_XGEN(b.x)]) == gen, bar);
            __builtin_amdgcn_fence(__ATOMIC_ACQUIRE, "agent");
            asm volatile("s_waitcnt vmcnt(0)" ::: "memory");
        }
    }
    __syncthreads();
}

using pg8::bf16_t; using pg8::bf16x8; using pg8::f32x4; using pg8::u32x4; using pg8::Unit; using pg8::Gemm; using pg8::cvt_pk_bf16;
typedef float f32x16 __attribute__((ext_vector_type(16)));
typedef unsigned u32x2 __attribute__((ext_vector_type(2)));

constexpr int DM = 1024, FF = 2816, MROWS = 34816, MH = 17408, NLAT = 32768;
constexpr float ALPHA = 1.4142135623730951f;
constexpr float LAM_INIT = 0.35550907f;
constexpr float QSCALE = 0.18033688011112042f;
constexpr int LDS_BYTES = 131072;

constexpr size_t SZ_WFI = (size_t)5632 * 1024 * 2, SZ_WFO = (size_t)1024 * 2816 * 2;
constexpr size_t OFF_WFI = 0;
constexpr size_t OFF_WFO = OFF_WFI + 4 * SZ_WFI;
constexpr size_t OFF_WEI = OFF_WFO + 4 * SZ_WFO;
constexpr size_t OFF_WEO = OFF_WEI + (size_t)4608 * 1024 * 2;
constexpr size_t OFF_WOI = OFF_WEO + (size_t)1024 * 1024 * 2;
constexpr size_t OFF_WOO = OFF_WOI + (size_t)3072 * 1024 * 2;
constexpr size_t OFF_HCTX = OFF_WOO + (size_t)1024 * 1024 * 2;
constexpr size_t OFF_MODP = OFF_HCTX + (size_t)2048 * 1024 * 4;
constexpr size_t OFF_MODV = OFF_MODP + (size_t)32 * 2 * 9 * 9216 * 4;
constexpr size_t OFF_ROPE = OFF_MODV + (size_t)2 * 9 * 9216 * 4;
constexpr size_t OFF_MISC = OFF_ROPE + (size_t)4096 * 64 * 4;
constexpr size_t OFF_BAR = OFF_MISC + 4096;
constexpr size_t OFF_LW = OFF_BAR + 16384;
constexpr size_t OFF_ABF = OFF_LW + 368640;
constexpr size_t OFF_BIG = OFF_ABF + (size_t)MROWS * 1024 * 2;
constexpr size_t OFF_HID = OFF_BIG;
constexpr size_t OFF_OUTF = OFF_BIG + (size_t)MROWS * FF * 2;
constexpr size_t WS_NEED = OFF_OUTF + (size_t)MROWS * 1024 * 4;
constexpr size_t SZ_PU = (size_t)MH * 512 * 2;
constexpr size_t OFF_U = OFF_BIG;
constexpr size_t OFF_PR = OFF_U + (size_t)MH * 4608 * 2;
constexpr size_t OFF_PK = OFF_PR + SZ_PU, OFF_PV = OFF_PK + SZ_PU, OFF_PKK = OFF_PV + SZ_PU, OFF_PBB = OFF_PKK + SZ_PU;
constexpr size_t OFF_PEW = OFF_PBB + SZ_PU;
constexpr size_t OFF_PG = OFF_PEW + 2 * SZ_PU;
constexpr size_t OFF_Y0 = OFF_PG + SZ_PU, OFF_Y1 = OFF_Y0 + SZ_PU;
constexpr size_t OFF_O0 = OFF_PR, OFF_O1 = OFF_PK;
constexpr size_t OFF_U3 = OFF_BIG;
constexpr size_t OFF_VT = OFF_U3 + (size_t)MROWS * 3072 * 2;

struct ParamsS {
    const float *x, *c, *ctx, *cctx, *w_mod, *b_mod, *ln_g, *ln_b, *ffn_w_in, *ffn_w_out, *ev_w_in, *ev_w_out, *rw_mu, *rw_w0, *rw_w2, *rw_a0, *rw_a2, *rw_g2,
        *rw_k_k, *rw_k_a, *rw_r_k, *rw_gn_g, *rw_gn_b, *hg_lb, *hg_norm_g, *od_w_in, *od_w_out, *da_lambda, *da_norm_g;
    float* out;
    char* ws;
};
typedef const __attribute__((address_space(4))) ParamsS Params;

DI float bf2f(bf16_t v) { return __uint_as_float((unsigned)v << 16); }
DI bf16_t f2bf(float f) { unsigned u = __float_as_uint(f); u += 0x7FFFu + ((u >> 16) & 1u); return (bf16_t)(u >> 16); }
DI float lo2f(unsigned w) { return __uint_as_float(w << 16); }
DI float hi2f(unsigned w) { return __uint_as_float(w & 0xFFFF0000u); }
DI float sigmoidf_(float x) { return __builtin_amdgcn_rcpf(1.f + __builtin_amdgcn_exp2f(-1.4426950408889634f * x)); }
DI float dpp_sum16(float x) {
    x += __int_as_float(__builtin_amdgcn_update_dpp(0, __float_as_int(x), 0xB1, 0xF, 0xF, true));
    x += __int_as_float(__builtin_amdgcn_update_dpp(0, __float_as_int(x), 0x4E, 0xF, 0xF, true));
    x += __int_as_float(__builtin_amdgcn_update_dpp(0, __float_as_int(x), 0x141, 0xF, 0xF, true));
    x += __int_as_float(__builtin_amdgcn_update_dpp(0, __float_as_int(x), 0x140, 0xF, 0xF, true));
    return x;
}
DI float wave_sum(float v) {
    v = dpp_sum16(v);
    v += __int_as_float(__builtin_amdgcn_update_dpp(0, __float_as_int(v), 0x142, 0xA, 0xF, false));
    v += __int_as_float(__builtin_amdgcn_update_dpp(0, __float_as_int(v), 0x143, 0xC, 0xF, false));
    return __int_as_float(__builtin_amdgcn_readlane(__float_as_int(v), 63));
}
DI void lds_barrier() { asm volatile("s_waitcnt lgkmcnt(0)" ::: "memory"); __builtin_amdgcn_s_barrier(); asm volatile("" ::: "memory"); }
DI void row_info(int rho, int& b, int& t, int& isctx) {
    const int half = rho >= MH ? 1 : 0; int q = rho - half * MH;
    if (q < 16384) { isctx = 0; b = half * 4 + (q >> 12); t = q & 4095; }
    else { q -= 16384; isctx = 1; b = half * 4 + (q >> 8); t = q & 255; }
}
DI float* h_ptr(Params& p, int b, int t, int isctx) {
    return isctx ? (float*)(p.ws + OFF_HCTX) + ((size_t)b * 256 + t) * 1024 : p.out + ((size_t)b * 4096 + t) * 1024;
}
DI const float* in_ptr(Params& p, int b, int t, int isctx) {
    return isctx ? p.ctx + ((size_t)b * 256 + t) * 1024 : p.x + ((size_t)b * 4096 + t) * 1024;
}

struct Order {
    int nM, nN, nwg, G, c, skipctx;
    DI void init(int M, int N, int G_, int c_, int skip) { nM = M / 256; nN = N / 256; nwg = nM * nN; G = G_; c = c_; skipctx = skip; }
    DI bool next(int i, Unit& u) const {
        const long L = (long)i * G + c; if (L >= nwg) return false;
        int wgid = (int)L; { const int q = nwg / 8, r = nwg % 8, xcd = wgid % 8, off = wgid / 8; wgid = (xcd < r ? xcd * (q + 1) : r * (q + 1) + (xcd - r) * q) + off; }
        const int nig = 8 * nN, gid = wgid / nig, fm = gid * 8, gsz = (nM - fm) < 8 ? (nM - fm) : 8;
        u.pm = fm + ((wgid % nig) % gsz); u.pn = (wgid % nig) / gsz;
        if (skipctx == 1) u.pm += 4 * (u.pm >> 6);
        else if (skipctx == 2) u.pm = 64 + (u.pm & 3) + 68 * (u.pm >> 2);
        return true;
    }
    DI void a_ready(const Unit&) const {}
    DI void done(const Unit&) const {}
};

struct EpiSwiglu {
    static constexpr bool PERM = true, AFTER_DRAIN = false;
    bf16_t* O; int ldc;
    DI void operator()(const f32x4 (&acc)[2][2][4][2], const Unit& u, int wr, int wc, int fr, int fq) const {
        const int row0 = u.pm * 256 + wr * 64 + fr; const int col0 = (u.pn * 256 + wc * 32 + 8 * fq) >> 1;
#pragma unroll
        for (int ai = 0; ai < 2; ++ai)
#pragma unroll
            for (int m = 0; m < 4; ++m) { bf16_t* rowp = O + (size_t)(row0 + ai * 128 + m * 16) * ldc + col0;
#pragma unroll
                for (int bj = 0; bj < 2; ++bj) { const f32x4 v0 = acc[ai][bj][m][0], v1 = acc[ai][bj][m][1];
                    const float h0 = v0[0] * sigmoidf_(v0[0]) * v0[1], h1 = v0[2] * sigmoidf_(v0[2]) * v0[3];
                    const float h2 = v1[0] * sigmoidf_(v1[0]) * v1[1], h3 = v1[2] * sigmoidf_(v1[2]) * v1[3];
                    u32x2 w; w.x = cvt_pk_bf16(h0, h1); w.y = cvt_pk_bf16(h2, h3);
                    *(u32x2*)(rowp + bj * 64) = w; } }
    }
};

struct EpiEven {
    static constexpr bool PERM = true, AFTER_DRAIN = false;
    bf16_t* O; int ldc; const float* lb;
    DI void operator()(const f32x4 (&acc)[2][2][4][2], const Unit& u, int wr, int wc, int fr, int fq) const {
        const int row0 = u.pm * 256 + wr * 64 + fr; const int col0 = u.pn * 256 + wc * 32 + 8 * fq;
        const int cls = u.pn < 8 ? 0 : (u.pn < 10 ? 1 : (u.pn < 14 ? 2 : (u.pn < 16 ? 0 : 1)));
        f32x4 om[2][2];
#pragma unroll
        for (int bj = 0; bj < 2; ++bj)
#pragma unroll
            for (int n = 0; n < 2; ++n) { om[bj][n] = (f32x4){1.f, 1.f, 1.f, 1.f}; if (cls == 2) om[bj][n] = om[bj][n] - *(const f32x4*)(lb + ((col0 + bj * 128 + 4 * n - 2560) & 511)); }
#pragma unroll
        for (int ai = 0; ai < 2; ++ai)
#pragma unroll
            for (int m = 0; m < 4; ++m) { bf16_t* rowp = O + (size_t)(row0 + ai * 128 + m * 16) * ldc + col0;
#pragma unroll
                for (int bj = 0; bj < 2; ++bj) { f32x4 v0 = acc[ai][bj][m][0], v1 = acc[ai][bj][m][1];
                    if (cls == 1) {
#pragma unroll
                        for (int i = 0; i < 4; ++i) { v0[i] = v0[i] * sigmoidf_(v0[i]); v1[i] = v1[i] * sigmoidf_(v1[i]); } }
                    else if (cls == 2) {
#pragma unroll
                        for (int i = 0; i < 4; ++i) { v0[i] = om[bj][0][i] * sigmoidf_(-v0[i]); v1[i] = om[bj][1][i] * sigmoidf_(-v1[i]); } }
                    u32x4 w; w.x = cvt_pk_bf16(v0[0], v0[1]); w.y = cvt_pk_bf16(v0[2], v0[3]); w.z = cvt_pk_bf16(v1[0], v1[1]); w.w = cvt_pk_bf16(v1[2], v1[3]);
                    *(u32x4*)(rowp + bj * 128) = w; } }
    }
};

struct EpiOdd {
    static constexpr bool PERM = true, AFTER_DRAIN = false;
    bf16_t* O; bf16_t* VT; const float* rope;
    DI void operator()(const f32x4 (&acc)[2][2][4][2], const Unit& u, int wr, int wc, int fr, int fq) const {
        const int col0 = u.pn * 256 + wc * 32 + 8 * fq;
#pragma unroll
        for (int ai = 0; ai < 2; ++ai)
#pragma unroll
            for (int m = 0; m < 4; ++m) { const int rho = u.pm * 256 + wr * 64 + fr + ai * 128 + m * 16; int b, t, ic; row_info(rho, b, t, ic);
                if (u.pn < 8) { bf16_t* rowp = O + (size_t)rho * 3072 + col0; const float* tab = rope + t * 64; const float sc = u.pn < 4 ? QSCALE : 1.f;
#pragma unroll
                    for (int bj = 0; bj < 2; ++bj) { f32x4 v0 = acc[ai][bj][m][0], v1 = acc[ai][bj][m][1];
                        if (!ic) { const int cc = (col0 + bj * 128) & 63; const int ti = (cc >> 5) * 16 + ((cc & 31) >> 1); const f32x4 cs = *(const f32x4*)(tab + ti), sn = *(const f32x4*)(tab + 32 + ti);
                            const f32x4 r0 = {v0[0] * cs[0] - v0[1] * sn[0], v0[1] * cs[0] + v0[0] * sn[0], v0[2] * cs[1] - v0[3] * sn[1], v0[3] * cs[1] + v0[2] * sn[1]};
                            const f32x4 r1 = {v1[0] * cs[2] - v1[1] * sn[2], v1[1] * cs[2] + v1[0] * sn[2], v1[2] * cs[3] - v1[3] * sn[3], v1[3] * cs[3] + v1[2] * sn[3]};
                            v0 = r0; v1 = r1; }
                        v0 = v0 * sc; v1 = v1 * sc;
                        u32x4 w; w.x = cvt_pk_bf16(v0[0], v0[1]); w.y = cvt_pk_bf16(v0[2], v0[3]); w.z = cvt_pk_bf16(v1[0], v1[1]); w.w = cvt_pk_bf16(v1[2], v1[3]);
                        *(u32x4*)(rowp + bj * 128) = w; }
                } else { const int s = ic ? t : 256 + t; const int kk = s & 15; const int pos = (s & ~15) | (kk < 4 ? kk : (kk < 8 ? kk + 4 : (kk < 12 ? kk - 4 : kk)));
#pragma unroll
                    for (int bj = 0; bj < 2; ++bj) { const int cv = col0 + bj * 128 - 2048; bf16_t* vp = VT + ((size_t)(b * 8 + (cv >> 7)) * 128 + (cv & 127)) * 4352 + pos;
                        const f32x4 v0 = acc[ai][bj][m][0], v1 = acc[ai][bj][m][1];
                        vp[0] = f2bf(v0[0]); vp[4352] = f2bf(v0[1]); vp[2 * 4352] = f2bf(v0[2]); vp[3 * 4352] = f2bf(v0[3]);
                        vp[4 * 4352] = f2bf(v1[0]); vp[5 * 4352] = f2bf(v1[1]); vp[6 * 4352] = f2bf(v1[2]); vp[7 * 4352] = f2bf(v1[3]); }
                }
            }
    }
};

DI void conv_tile(int tidx, const float* src, int Nsrc, int K, bf16_t* dst, int kind, int tile, float* lds) {
    const int nkt = K >> 8; const int nt = tile / nkt, kt = tile - nt * nkt; const int n0 = nt * 64, k0 = kt * 256;
    const int nn = tidx & 63, kq = tidx >> 6; const int n = n0 + nn; int col;
    if (kind == 1) col = (n & 1) ? (FF + (n >> 1)) : (n >> 1);
    else if (kind == 2) col = n < 1888 ? n : (n < 2048 ? -1 : n - 160);
    else if (kind == 3) { if (n < 2048) { const int pp = n & 63, q = pp & 31; col = (n & ~63) + (pp & 32) + (q >> 1) + 16 * (q & 1); } else col = n; }
    else col = n;
    __syncthreads();
#pragma unroll
    for (int hh = 0; hh < 2; ++hh) { float v[16];
#pragma unroll
        for (int i = 0; i < 16; ++i) v[i] = col >= 0 ? __builtin_nontemporal_load(src + (size_t)(k0 + kq + 8 * (hh * 16 + i)) * Nsrc + col) : 0.f;
#pragma unroll
        for (int i = 0; i < 16; ++i) lds[(kq + 8 * (hh * 16 + i)) * 65 + nn] = v[i]; }
    __syncthreads();
    const int n2 = tidx >> 3, ks = tidx & 7;
#pragma unroll
    for (int j = 0; j < 4; ++j) { const float* l = lds + (j * 64 + ks * 8) * 65 + n2;
        u32x4 w; w.x = cvt_pk_bf16(l[0], l[65]); w.y = cvt_pk_bf16(l[130], l[195]); w.z = cvt_pk_bf16(l[260], l[325]); w.w = cvt_pk_bf16(l[390], l[455]);
        *(u32x4*)(dst + (size_t)(n0 + n2) * K + k0 + j * 64 + ks * 8) = w; }
}

DI void phase_pre(int tidx, int bidx, Params& p, float* lds) {
    const int tid = tidx;
    float* part = (float*)(p.ws + OFF_MODP);
    for (int u = bidx; u < 1152; u += gridDim.x) {
        const int ks = u & 31, ct = (u >> 5) % 18, layer = u / 576;
        __syncthreads();
        for (int i = tid; i < 9 * 32; i += 512) { const int r = i >> 5, k = i & 31; const float cv = r < 8 ? p.c[r * 1024 + ks * 32 + k] : p.cctx[ks * 32 + k]; lds[i] = cv * sigmoidf_(cv); }
        __syncthreads();
        const int col = ct * 512 + tid; const float* w = p.w_mod + ((size_t)layer * 1024 + ks * 32) * 9216 + col;
        float a0 = 0, a1 = 0, a2 = 0, a3 = 0, a4 = 0, a5 = 0, a6 = 0, a7 = 0, a8 = 0;
#pragma unroll 8
        for (int k = 0; k < 32; ++k) { const float wv = __builtin_nontemporal_load(w + (size_t)k * 9216);
            a0 += lds[k] * wv; a1 += lds[32 + k] * wv; a2 += lds[64 + k] * wv; a3 += lds[96 + k] * wv; a4 += lds[128 + k] * wv; a5 += lds[160 + k] * wv; a6 += lds[192 + k] * wv; a7 += lds[224 + k] * wv; a8 += lds[256 + k] * wv; }
        float* o = part + ((size_t)(ks * 2 + layer) * 9) * 9216 + col;
        o[0] = a0; o[9216] = a1; o[2 * 9216] = a2; o[3 * 9216] = a3; o[4 * 9216] = a4; o[5 * 9216] = a5; o[6 * 9216] = a6; o[7 * 9216] = a7; o[8 * 9216] = a8;
    }
    for (int tI = bidx; tI < 2720; tI += gridDim.x) {
        if (tI < 1408) { const int w = tI / 352; conv_tile(tidx, p.ffn_w_in + (size_t)w * 1024 * 5632, 5632, 1024, (bf16_t*)(p.ws + OFF_WFI + w * SZ_WFI), 1, tI - w * 352, lds); }
        else if (tI < 2112) { const int q = tI - 1408, w = q / 176; conv_tile(tidx, p.ffn_w_out + (size_t)w * 2816 * 1024, 1024, 2816, (bf16_t*)(p.ws + OFF_WFO + w * SZ_WFO), 0, q - w * 176, lds); }
        else if (tI < 2400) conv_tile(tidx, p.ev_w_in, 4448, 1024, (bf16_t*)(p.ws + OFF_WEI), 2, tI - 2112, lds);
        else if (tI < 2464) conv_tile(tidx, p.ev_w_out, 1024, 1024, (bf16_t*)(p.ws + OFF_WEO), 0, tI - 2400, lds);
        else if (tI < 2656) conv_tile(tidx, p.od_w_in, 3072, 1024, (bf16_t*)(p.ws + OFF_WOI), 3, tI - 2464, lds);
        else conv_tile(tidx, p.od_w_out, 1024, 1024, (bf16_t*)(p.ws + OFF_WOO), 0, tI - 2656, lds);
    }
    { bf16_t* LW = (bf16_t*)(p.ws + OFF_LW);
      for (int i = bidx * 512 + tid; i < 512 * 352; i += gridDim.x * 512) {
          if (i < 32768) { const int c = i >> 6, k = i & 63; LW[i] = f2bf(p.rw_a2[k * 512 + c]); }
          else if (i < 98304) { const int q = i - 32768; const int d = q >> 15, c = (q >> 6) & 511, k = q & 63; LW[i] = f2bf(p.rw_w2[(d * 64 + k) * 512 + c]); }
          else { const int q = i - 98304; const int c = q / 160, k = q - c * 160; LW[i] = f2bf(p.rw_g2[k * 512 + c]); } } }
    float* rope = (float*)(p.ws + OFF_ROPE);
    for (int i = bidx * 512 + tid; i < 4096 * 32; i += gridDim.x * 512) {
        const int t = i >> 5, f = i & 31; const float pos = (float)((f < 16) ? (t >> 6) : (t & 63));
        const float inv = exp2f(-(float)(f & 15) * 0.8304820237218406f); const float ang = pos * inv;
        rope[t * 64 + f] = cosf(ang); rope[t * 64 + 32 + f] = sinf(ang);
    }
    if (bidx == 0) {
        float* misc = (float*)(p.ws + OFF_MISC);
        { const float l0 = p.hg_lb[tid], l1 = p.hg_lb[512 + tid], l2 = p.hg_lb[1024 + tid]; const float mx = fmaxf(l0, fmaxf(l1, l2));
          const float e0 = expf(l0 - mx), e1 = expf(l1 - mx), e2 = expf(l2 - mx); misc[tid] = e0 / (e0 + e1 + e2); }
        if (tid < 64) { const float s01 = wave_sum(p.da_lambda[tid] * p.da_lambda[64 + tid]); const float s23 = wave_sum(p.da_lambda[128 + tid] * p.da_lambda[192 + tid]);
            if (tid == 0) misc[512] = expf(s01) - expf(s23) + LAM_INIT; }
    }
}

DI void phase_modfin(int tidx, int bidx, Params& p) {
    const float* part = (const float*)(p.ws + OFF_MODP); float* mv = (float*)(p.ws + OFF_MODV);
    for (int i = bidx * 512 + tidx; i < 2 * 9 * 9216; i += gridDim.x * 512) {
        const int layer = i / (9 * 9216); const int col = i % 9216; float s = p.b_mod[layer * 9216 + col];
#pragma unroll 8
        for (int ks = 0; ks < 32; ++ks) s += part[(size_t)ks * 2 * 9 * 9216 + i];
        mv[i] = s;
    }
}

DI void phase_modin(int tidx, int bidx, Params& p) {
    const int wid = tidx >> 6, lane = tidx & 63; const float* mv = (const float*)(p.ws + OFF_MODV); bf16_t* abf = (bf16_t*)(p.ws + OFF_ABF);
    for (int rho = bidx * 8 + wid; rho < MROWS; rho += gridDim.x * 8) {
        int b, t, ic; row_info(rho, b, t, ic); const float* src = in_ptr(p, b, t, ic); const float* m = mv + (size_t)(ic ? 8 : b) * 9216;
#pragma unroll
        for (int i = 0; i < 4; ++i) { const int d = i * 256 + lane * 4; const f32x4 h = __builtin_nontemporal_load((const f32x4*)(src + d)), sh = *(const f32x4*)(m + d), sc = *(const f32x4*)(m + 1024 + d);
            u32x2 w; w.x = cvt_pk_bf16(h[0] * (1.f + sc[0]) + sh[0], h[1] * (1.f + sc[1]) + sh[1]); w.y = cvt_pk_bf16(h[2] * (1.f + sc[2]) + sh[2], h[3] * (1.f + sc[3]) + sh[3]);
            *(u32x2*)(abf + (size_t)rho * 1024 + d) = w; }
    }
}

DI void phase_postnorm(int tidx, int bidx, Params& p, int layer, int j, float wgt, int first, int nl, int nj, int rowmode, int wg0, int nwg) {
    const int wid = tidx >> 6, lane = tidx & 63; const float* mv = (const float*)(p.ws + OFF_MODV); bf16_t* abf = (bf16_t*)(p.ws + OFF_ABF);
    const bf16_t* outf = (const bf16_t*)(p.ws + OFF_OUTF); const float* lg = p.ln_g + (layer * 3 + j) * 1024; const float* lb = p.ln_b + (layer * 3 + j) * 1024;
    const int stride = nwg * 8; const int nrows = rowmode == 0 ? MROWS : (rowmode == 1 ? NLAT : 2048);
    for (int idx0 = (bidx - wg0) * 8 + wid; idx0 < nrows; idx0 += 2 * stride) {
        f32x4 v[2][4]; float s[2], q[2]; float* hd[2]; const float* m2[2]; bool ok[2]; int rr[2];
#pragma unroll
        for (int u = 0; u < 2; ++u) {
            const int idx = idx0 + u * stride; ok[u] = idx < nrows; const int ii = ok[u] ? idx : 0;
            const int rho = rowmode == 0 ? ii : (rowmode == 1 ? (ii >> 14) * MH + (ii & 16383) : (ii >> 10) * MH + 16384 + (ii & 1023)); rr[u] = rho; int b = 0, t = 0, ic = 0; row_info(rho, b, t, ic);
            const float* hp = first ? in_ptr(p, b, t, ic) : h_ptr(p, b, t, ic); hd[u] = h_ptr(p, b, t, ic);
            const float* m = mv + ((size_t)layer * 9 + (ic ? 8 : b)) * 9216 + j * 3072 + 2048; const bf16_t* o = outf + (size_t)rho * 1024;
            m2[u] = nl >= 0 ? mv + ((size_t)nl * 9 + (ic ? 8 : b)) * 9216 + nj * 3072 : mv;
            s[u] = 0.f; q[u] = 0.f;
            if (ok[u]) {
#pragma unroll
                for (int i = 0; i < 4; ++i) { const int d = i * 256 + lane * 4; const f32x4 h = __builtin_nontemporal_load((const f32x4*)(hp + d)), g = *(const f32x4*)(m + d); const u32x2 ow = __builtin_nontemporal_load((const u32x2*)(o + d)); const f32x4 ov = {lo2f(ow.x), hi2f(ow.x), lo2f(ow.y), hi2f(ow.y)};
                    v[u][i] = ALPHA * h + wgt * g * ov; s[u] += v[u][i][0] + v[u][i][1] + v[u][i][2] + v[u][i][3];
                    q[u] += v[u][i][0] * v[u][i][0] + v[u][i][1] * v[u][i][1] + v[u][i][2] * v[u][i][2] + v[u][i][3] * v[u][i][3]; }
            } else {
#pragma unroll
                for (int i = 0; i < 4; ++i) v[u][i] = (f32x4){0.f, 0.f, 0.f, 0.f};
            }
        }
#pragma unroll
        for (int u = 0; u < 2; ++u) {
            const float mu = wave_sum(s[u]) * (1.f / 1024.f); const float var = fmaxf(wave_sum(q[u]) * (1.f / 1024.f) - mu * mu, 0.f); const float rs = rsqrtf(var + 1e-5f);
            if (ok[u]) {
#pragma unroll
                for (int i = 0; i < 4; ++i) { const int d = i * 256 + lane * 4; const f32x4 hn = (v[u][i] - mu) * rs * *(const f32x4*)(lg + d) + *(const f32x4*)(lb + d);
                    __builtin_nontemporal_store(hn, (f32x4*)(hd[u] + d));
                    if (nl >= 0) { const f32x4 sh = *(const f32x4*)(m2[u] + d), sc = *(const f32x4*)(m2[u] + 1024 + d);
                        u32x2 w; w.x = cvt_pk_bf16(hn[0] * (1.f + sc[0]) + sh[0], hn[1] * (1.f + sc[1]) + sh[1]); w.y = cvt_pk_bf16(hn[2] * (1.f + sc[2]) + sh[2], hn[3] * (1.f + sc[3]) + sh[3]);
                        *(u32x2*)(abf + (size_t)rr[u] * 1024 + d) = w; } }
            }
        }
    }
}

DI int scan_row(int gs, int bl, int d) {
    if (gs < 256) return 16384 + bl * 256 + (d ? 255 - gs : gs);
    const int t = gs - 256; return bl * 4096 + (d ? 4095 - t : t);
}
DI void cvt8(const u32x4 w, float* o) { o[0] = lo2f(w.x); o[1] = hi2f(w.x); o[2] = lo2f(w.y); o[3] = hi2f(w.y); o[4] = lo2f(w.z); o[5] = hi2f(w.z); o[6] = lo2f(w.w); o[7] = hi2f(w.w); }

typedef float f32x2 __attribute__((ext_vector_type(2)));
#define ST8(dst, f) do { *(f32x4*)(dst) = (f32x4){f[0], f[1], f[2], f[3]}; *(f32x4*)((dst) + 4) = (f32x4){f[4], f[5], f[6], f[7]}; } while (0)
DI float dpp_sum8(float x) {
    x += __int_as_float(__builtin_amdgcn_update_dpp(0, __float_as_int(x), 0xB1, 0xF, 0xF, true));
    x += __int_as_float(__builtin_amdgcn_update_dpp(0, __float_as_int(x), 0x4E, 0xF, 0xF, true));
    x += __int_as_float(__builtin_amdgcn_update_dpp(0, __float_as_int(x), 0x141, 0xF, 0xF, true));
    return x;
}
#define P2(v, i) ((f32x2){(v)[i], (v)[(i) + 1]})
DI void phase_scan(int tidx, int bidx, Params& p, float* lds) {
    const int tid = tidx, wid = tid >> 6, lane = tid & 63; const int li = tid - 256, lstep = li >> 3, lgrp = li & 7;
    bf16_t* Ub = (bf16_t*)(p.ws + OFF_U);
    for (int unit = bidx; unit < 256; unit += gridDim.x) {
        __syncthreads();
        if (unit < 128) {
            constexpr int ST = 356, BUF = 32 * ST;
            const bf16_t* PR = (const bf16_t*)(p.ws + OFF_PR); const bf16_t* PK = (const bf16_t*)(p.ws + OFF_PK); const bf16_t* PV = (const bf16_t*)(p.ws + OFF_PV);
            const bf16_t* PKK = (const bf16_t*)(p.ws + OFF_PKK); const bf16_t* PBB = (const bf16_t*)(p.ws + OFF_PBB); const __half* PEW = (const __half*)(p.ws + OFF_PEW);
            const int rh = (unit >> 3) & 1, scan = (unit >> 4) * 8 + (unit & 7); const int d = scan & 1, h = (scan >> 1) & 7, bl = scan >> 4;
            bf16_t* Y = Ub + 1024 + d * 512 + h * 64 + rh * 32;
            const int ks = lane & 7, rowl = wid * 8 + (lane >> 3);
            f32x2 S0 = {0.f, 0.f}, S1 = {0.f, 0.f}, S2 = {0.f, 0.f}, S3 = {0.f, 0.f};
            u32x4 A0, A1, A2, A3, A4, A5; A0 = A1 = A2 = A3 = A4 = A5 = (u32x4){0u, 0u, 0u, 0u}; int Arow = 0;
            u32x4 B0, B1, B2, B3, B4, B5; B0 = B1 = B2 = B3 = B4 = B5 = (u32x4){0u, 0u, 0u, 0u}; int Brow = 0;
#define RW_LOAD(ch, G) do { G##row = scan_row((ch) * 32 + lstep, bl, d); const size_t o = (size_t)G##row * 512 + h * 64 + lgrp * 8; \
                G##0 = *(const u32x4*)(PR + o); G##1 = *(const u32x4*)(PK + o); G##2 = *(const u32x4*)(PKK + o); G##3 = *(const u32x4*)(PBB + o); \
                G##4 = *(const u32x4*)(PEW + ((size_t)G##row * 2 + d) * 512 + h * 64 + lgrp * 8); \
                if (lgrp < 4) G##5 = *(const u32x4*)(PV + (size_t)G##row * 512 + h * 64 + rh * 32 + lgrp * 8); } while (0)
#define RW_STORE(bi, C) do { float* dst = lds + (bi) * BUF + lstep * ST; float f[8]; \
                cvt8(C##0, f); ST8(dst + lgrp * 8, f); \
                { const __half2* e2 = (const __half2*)&C##4; _Pragma("unroll") for (int q = 0; q < 4; ++q) { const float2 ef = __half22float2(e2[q]); f[2 * q] = __expf(-ef.x); f[2 * q + 1] = __expf(-ef.y); } } \
                ST8(dst + 64 + lgrp * 8, f); cvt8(C##1, f); ST8(dst + 128 + lgrp * 8, f); \
                cvt8(C##2, f); _Pragma("unroll") for (int q = 0; q < 8; ++q) f[q] = -f[q]; ST8(dst + 192 + lgrp * 8, f); cvt8(C##3, f); ST8(dst + 256 + lgrp * 8, f); \
                if (lgrp < 4) { cvt8(C##5, f); ST8(dst + 320 + lgrp * 8, f); } if (lgrp == 0) ((int*)dst)[352] = C##row; } while (0)
            if (tid >= 256) {
                RW_LOAD(0, A); RW_LOAD(1, B); RW_STORE(0, A);
                lds_barrier();
                for (int ch = 0; ch < 136; ch += 2) {
                    { const int cn = ch + 2 < 136 ? ch + 2 : 135; RW_LOAD(cn, A); } RW_STORE(1, B); lds_barrier();
                    { const int cn = ch + 3 < 136 ? ch + 3 : 135; RW_LOAD(cn, B); } RW_STORE(0, A); lds_barrier();
                }
            } else {
                lds_barrier();
                for (int ch = 0; ch < 136; ++ch) {
                {
                    const float* buf = lds + (ch & 1) * BUF;
                    f32x4 nra = *(const f32x4*)(buf + ks * 8), nrb = *(const f32x4*)(buf + ks * 8 + 4), nwa = *(const f32x4*)(buf + 64 + ks * 8), nwb = *(const f32x4*)(buf + 64 + ks * 8 + 4);
                    f32x4 nka = *(const f32x4*)(buf + 128 + ks * 8), nkb = *(const f32x4*)(buf + 128 + ks * 8 + 4), nza = *(const f32x4*)(buf + 192 + ks * 8), nzb = *(const f32x4*)(buf + 192 + ks * 8 + 4);
                    f32x4 nba = *(const f32x4*)(buf + 256 + ks * 8), nbb = *(const f32x4*)(buf + 256 + ks * 8 + 4); float nv = buf[320 + rowl];
                    float sa; { f32x2 dz = S0 * P2(nza, 0); dz = S1 * P2(nza, 2) + dz; dz = S2 * P2(nzb, 0) + dz; dz = S3 * P2(nzb, 2) + dz; sa = dpp_sum8(dz[0] + dz[1]); }
                    for (int sh = 0; sh < 4; ++sh) {
                        float ykeep = 0.f;
#pragma unroll 2
                        for (int s = 0; s < 8; ++s) {
                            const f32x4 ra = nra, rb = nrb, wa = nwa, wb = nwb, ka = nka, kb = nkb, ba = nba, bb = nbb; const float vv = nv;
                            { const float* bq = buf + (sh * 8 + s + 1) * ST;
                              nra = *(const f32x4*)(bq + ks * 8); nrb = *(const f32x4*)(bq + ks * 8 + 4); nwa = *(const f32x4*)(bq + 64 + ks * 8); nwb = *(const f32x4*)(bq + 64 + ks * 8 + 4);
                              nka = *(const f32x4*)(bq + 128 + ks * 8); nkb = *(const f32x4*)(bq + 128 + ks * 8 + 4); nza = *(const f32x4*)(bq + 192 + ks * 8); nzb = *(const f32x4*)(bq + 192 + ks * 8 + 4);
                              nba = *(const f32x4*)(bq + 256 + ks * 8); nbb = *(const f32x4*)(bq + 256 + ks * 8 + 4); nv = bq[320 + rowl]; }
                            const f32x2 vv2 = {vv, vv}, sa2 = {sa, sa};
                            S0 = S0 * P2(wa, 0) + (sa2 * P2(ba, 0) + vv2 * P2(ka, 0)); S1 = S1 * P2(wa, 2) + (sa2 * P2(ba, 2) + vv2 * P2(ka, 2));
                            S2 = S2 * P2(wb, 0) + (sa2 * P2(bb, 0) + vv2 * P2(kb, 0)); S3 = S3 * P2(wb, 2) + (sa2 * P2(bb, 2) + vv2 * P2(kb, 2));
                            f32x2 dy = S0 * P2(ra, 0); dy = S1 * P2(ra, 2) + dy; dy = S2 * P2(rb, 0) + dy; dy = S3 * P2(rb, 2) + dy;
                            f32x2 dz = S0 * P2(nza, 0); dz = S1 * P2(nza, 2) + dz; dz = S2 * P2(nzb, 0) + dz; dz = S3 * P2(nzb, 2) + dz;
                            float yy = dy[0] + dy[1], zz = dz[0] + dz[1];
                            yy += __int_as_float(__builtin_amdgcn_update_dpp(0, __float_as_int(yy), 0xB1, 0xF, 0xF, true)); zz += __int_as_float(__builtin_amdgcn_update_dpp(0, __float_as_int(zz), 0xB1, 0xF, 0xF, true));
                            yy += __int_as_float(__builtin_amdgcn_update_dpp(0, __float_as_int(yy), 0x4E, 0xF, 0xF, true)); zz += __int_as_float(__builtin_amdgcn_update_dpp(0, __float_as_int(zz), 0x4E, 0xF, 0xF, true));
                            yy += __int_as_float(__builtin_amdgcn_update_dpp(0, __float_as_int(yy), 0x141, 0xF, 0xF, true)); zz += __int_as_float(__builtin_amdgcn_update_dpp(0, __float_as_int(zz), 0x141, 0xF, 0xF, true));
                            sa = zz;
                            ykeep = (s == ks) ? yy : ykeep;
                        }
                        const int row = ((const int*)(buf + (sh * 8 + ks) * ST))[352];
                        Y[(size_t)row * 4608 + rowl] = f2bf(ykeep);
                    }
                }
                lds_barrier();
                }
            }
        } else {
            constexpr int ST = 292, BUF = 32 * ST;
            const bf16_t* U = Ub + 2048; const float* lbv = (const float*)(p.ws + OFF_MISC);
            const int u2 = unit - 128; const int vq = (u2 >> 3) & 3, scan = (u2 >> 5) * 8 + (u2 & 7); const int d = scan & 1, h = (scan >> 1) & 3, bl = scan >> 3;
            bf16_t* O = Ub + d * 512 + h * 128 + vq * 32;
            const int ksl = lane & 7, vcol = wid * 8 + (lane >> 3);
            f32x2 S[8];
#pragma unroll
            for (int q = 0; q < 8; ++q) S[q] = (f32x2){0.f, 0.f};
            u32x4 A0, A1, A2, A3, A4; A0 = A1 = A2 = A3 = A4 = (u32x4){0u, 0u, 0u, 0u}; int Arow = 0;
            u32x4 B0, B1, B2, B3, B4; B0 = B1 = B2 = B3 = B4 = (u32x4){0u, 0u, 0u, 0u}; int Brow = 0;
#define HG_LOAD(ch, G) do { G##row = scan_row((ch) * 32 + lstep, bl, d); const bf16_t* ur = U + (size_t)G##row * 4608; \
                G##0 = *(const u32x4*)(ur + h * 128 + lgrp * 16); G##1 = *(const u32x4*)(ur + h * 128 + lgrp * 16 + 8); \
                G##2 = *(const u32x4*)(ur + 512 + d * 512 + h * 128 + lgrp * 16); G##3 = *(const u32x4*)(ur + 512 + d * 512 + h * 128 + lgrp * 16 + 8); \
                if (lgrp < 4) G##4 = *(const u32x4*)(ur + 1536 + h * 128 + vq * 32 + lgrp * 8); } while (0)
#define HG_STORE(bi, C) do { float* dst = lds + (bi) * BUF + lstep * ST; float f[8]; \
                cvt8(C##0, f); ST8(dst + lgrp * 16, f); \
                cvt8(C##1, f); ST8(dst + lgrp * 16 + 8, f); \
                cvt8(C##2, f); _Pragma("unroll") for (int q = 0; q < 8; ++q) f[q] = 1.f - f[q]; ST8(dst + 128 + lgrp * 16, f); \
                cvt8(C##3, f); _Pragma("unroll") for (int q = 0; q < 8; ++q) f[q] = 1.f - f[q]; ST8(dst + 128 + lgrp * 16 + 8, f); \
                if (lgrp < 4) { cvt8(C##4, f); ST8(dst + 256 + lgrp * 8, f); } if (lgrp == 0) ((int*)dst)[288] = C##row; } while (0)
            if (tid >= 256) {
                HG_LOAD(0, A); HG_LOAD(1, B); HG_STORE(0, A);
                lds_barrier();
                for (int ch = 0; ch < 136; ch += 2) {
                    { const int cn = ch + 2 < 136 ? ch + 2 : 135; HG_LOAD(cn, A); } HG_STORE(1, B); lds_barrier();
                    { const int cn = ch + 3 < 136 ? ch + 3 : 135; HG_LOAD(cn, B); } HG_STORE(0, A); lds_barrier();
                }
            } else {
                lds_barrier();
                for (int ch = 0; ch < 136; ++ch) {
                {
                    const float* buf = lds + (ch & 1) * BUF;
                    f32x4 nq[4], nf[4];
#pragma unroll
                    for (int q = 0; q < 4; ++q) { nq[q] = *(const f32x4*)(buf + ksl * 16 + q * 4); nf[q] = *(const f32x4*)(buf + 128 + ksl * 16 + q * 4); }
                    float niv = buf[256 + vcol];
                    for (int sh = 0; sh < 4; ++sh) {
                        float okeep = 0.f;
#pragma unroll 2
                        for (int s = 0; s < 8; ++s) {
                            f32x4 cq[4], cf[4];
#pragma unroll
                            for (int q = 0; q < 4; ++q) { cq[q] = nq[q]; cf[q] = nf[q]; }
                            const float iv = niv;
                            { const float* bq = buf + (sh * 8 + s + 1) * ST;
#pragma unroll
                              for (int q = 0; q < 4; ++q) { nq[q] = *(const f32x4*)(bq + ksl * 16 + q * 4); nf[q] = *(const f32x4*)(bq + 128 + ksl * 16 + q * 4); }
                              niv = bq[256 + vcol]; }
                            const f32x2 iv2 = {iv, iv}; f32x2 o2 = {0.f, 0.f};
#pragma unroll
                            for (int q = 0; q < 4; ++q) {
                                const f32x2 fa = P2(cf[q], 0), fb = P2(cf[q], 2);
                                S[2 * q] = fa * S[2 * q] + (iv2 - fa * iv2); S[2 * q + 1] = fb * S[2 * q + 1] + (iv2 - fb * iv2);
                                o2 = S[2 * q] * P2(cq[q], 0) + o2; o2 = S[2 * q + 1] * P2(cq[q], 2) + o2;
                            }
                            const float o = dpp_sum8(o2[0] + o2[1]);
                            okeep = (s == ksl) ? o : okeep;
                        }
                        const int row = ((const int*)(buf + (sh * 8 + ksl) * ST))[288];
                        O[(size_t)row * 4608 + vcol] = f2bf(okeep);
                    }
                }
                lds_barrier();
                }
            }
        }
    }
}

DI void ld8bf(const bf16_t* p, float* o) { const u32x4 w = *(const u32x4*)p; cvt8(w, o); }
DI void ld8bf_nt(const bf16_t* p, float* o) { const u32x4 w = __builtin_nontemporal_load((const u32x4*)p); cvt8(w, o); }
DI void ld8f(const float* p, float* o) { const f32x4 a = *(const f32x4*)p, b = *(const f32x4*)(p + 4); o[0] = a[0]; o[1] = a[1]; o[2] = a[2]; o[3] = a[3]; o[4] = b[0]; o[5] = b[1]; o[6] = b[2]; o[7] = b[3]; }
DI u32x4 pack8(const float* f) { u32x4 w; w.x = cvt_pk_bf16(f[0], f[1]); w.y = cvt_pk_bf16(f[2], f[3]); w.z = cvt_pk_bf16(f[4], f[5]); w.w = cvt_pk_bf16(f[6], f[7]); return w; }
DI void shifted8(const bf16_t* U, size_t r, int col, int t, int T, const float* mu, float* o) {
    float c[8], a[8], b[8]; ld8bf(U + r * 4608 + col, c);
    if (t > 0) ld8bf(U + (r - 1) * 4608 + col, a); else {
#pragma unroll
        for (int q = 0; q < 8; ++q) a[q] = 0.f; }
    if (t < T - 1) ld8bf(U + (r + 1) * 4608 + col, b); else {
#pragma unroll
        for (int q = 0; q < 8; ++q) b[q] = 0.f; }
#pragma unroll
    for (int q = 0; q < 8; ++q) o[q] = c[q] + mu[q] * (0.5f * (a[q] + b[q]) - c[q]);
}
#define MFMA32(a, b, c) __builtin_amdgcn_mfma_f32_32x32x16_bf16((a), (b), (c), 0, 0, 0)
#define LORA_MFMA(WT, KT, KB, NS) do { _Pragma("unroll") for (int n = 0; n < 2; ++n) _Pragma("unroll") for (int r = 0; r < 16; ++r) acc[n][r] = 0.f; \
    bf16x8 bfr_[2][NS]; _Pragma("unroll") for (int st = 0; st < (NS); ++st) _Pragma("unroll") for (int n = 0; n < 2; ++n) bfr_[n][st] = *(const bf16x8*)((WT) + (size_t)(wid * 64 + n * 32 + l31) * (KT) + st * 16 + hf * 8); \
    _Pragma("unroll") for (int st = 0; st < (NS); ++st) { const bf16x8 af = *(const bf16x8*)(inl + l31 * 360 + (KB) + st * 16 + hf * 8); \
        _Pragma("unroll") for (int n = 0; n < 2; ++n) acc[n] = MFMA32(af, bfr_[n][st], acc[n]); } } while (0)

DI void phase_rwprep(int tidx, int bidx, Params& p, char* ldsb) {
    const int tid = tidx, wid = tid >> 6, lane = tid & 63, l31 = lane & 31, hf = lane >> 5; const bf16_t* U = (const bf16_t*)(p.ws + OFF_U);
    bf16_t* PR = (bf16_t*)(p.ws + OFF_PR); bf16_t* PK = (bf16_t*)(p.ws + OFF_PK); bf16_t* PV = (bf16_t*)(p.ws + OFF_PV); bf16_t* PKK = (bf16_t*)(p.ws + OFF_PKK); bf16_t* PBB = (bf16_t*)(p.ws + OFF_PBB);
    __half* PEW = (__half*)(p.ws + OFF_PEW); bf16_t* PG = (bf16_t*)(p.ws + OFF_PG);
    const bf16_t* LW = (const bf16_t*)(p.ws + OFF_LW); const bf16_t* a2T = LW; const bf16_t* w2T = LW + 32768; const bf16_t* g2T = LW + 98304;
    bf16_t* inl = (bf16_t*)ldsb; float* al = (float*)(ldsb + 23040);
    const int c0 = (tid & 63) * 8;
    float mur[8], muk[8], muv[8], kkc[8], kac[8];
    ld8f(p.rw_mu + c0, mur); ld8f(p.rw_mu + 512 + c0, muk); ld8f(p.rw_mu + 1024 + c0, muv); ld8f(p.rw_k_k + c0, kkc); ld8f(p.rw_k_a + c0, kac);
    for (int tile = bidx; tile < 544; tile += gridDim.x) {
        int row0, t0, T;
        if (tile < 512) { row0 = tile * 32; t0 = row0 & 4095; T = 4096; } else { row0 = 16384 + (tile - 512) * 32; t0 = ((tile - 512) * 32) & 255; T = 256; }
        __syncthreads();
        for (int i = tid; i < 32 * 44; i += 512) { const int tok = i / 44, g = i - tok * 44; float mu[8], x[8]; ld8f(p.rw_mu + 1536 + g * 8, mu);
            shifted8(U, (size_t)(row0 + tok), 1536 + g * 8, t0 + tok, T, mu, x);
#pragma unroll
            for (int q = 0; q < 8; ++q) x[q] = g < 16 ? tanhf(x[q]) : (g < 24 ? x[q] : sigmoidf_(x[q]));
            *(u32x4*)(inl + tok * 360 + g * 8) = pack8(x); }
        __syncthreads();
        f32x16 acc[2];
        LORA_MFMA(a2T, 64, 128, 4);
#pragma unroll
        for (int n = 0; n < 2; ++n) { const int c = wid * 64 + n * 32 + l31; const float a0c = p.rw_a0[c];
#pragma unroll
            for (int r = 0; r < 16; ++r) al[(8 * (r >> 2) + 4 * hf + (r & 3)) * 516 + c] = sigmoidf_(a0c + acc[n][r]); }
        LORA_MFMA(w2T, 64, 0, 4);
#pragma unroll
        for (int n = 0; n < 2; ++n) { const int c = wid * 64 + n * 32 + l31; const float w0c = p.rw_w0[c];
#pragma unroll
            for (int r = 0; r < 16; ++r) PEW[((size_t)(row0 + 8 * (r >> 2) + 4 * hf + (r & 3)) * 2 + 0) * 512 + c] = __float2half(0.6065306597126334f * sigmoidf_(w0c + acc[n][r])); }
        LORA_MFMA(w2T + 32768, 64, 64, 4);
#pragma unroll
        for (int n = 0; n < 2; ++n) { const int c = wid * 64 + n * 32 + l31; const float w0c = p.rw_w0[512 + c];
#pragma unroll
            for (int r = 0; r < 16; ++r) PEW[((size_t)(row0 + 8 * (r >> 2) + 4 * hf + (r & 3)) * 2 + 1) * 512 + c] = __float2half(0.6065306597126334f * sigmoidf_(w0c + acc[n][r])); }
        LORA_MFMA(g2T, 160, 192, 10);
#pragma unroll
        for (int n = 0; n < 2; ++n) { const int c = wid * 64 + n * 32 + l31;
#pragma unroll
            for (int r = 0; r < 16; ++r) PG[(size_t)(row0 + 8 * (r >> 2) + 4 * hf + (r & 3)) * 512 + c] = f2bf(acc[n][r]); }
        __syncthreads();
#pragma unroll 1
        for (int q4 = 0; q4 < 4; ++q4) { const int tok = (tid >> 6) + 8 * q4; const size_t r = (size_t)(row0 + tok); const int t = t0 + tok;
            float rr[8], kr[8], vr[8], a[8], o1[8], o2[8];
            shifted8(U, r, c0, t, T, mur, rr); shifted8(U, r, 512 + c0, t, T, muk, kr); shifted8(U, r, 1024 + c0, t, T, muv, vr); ld8f(al + tok * 516 + c0, a);
            float ss = 0.f;
#pragma unroll
            for (int q = 0; q < 8; ++q) { o1[q] = kr[q] * kkc[q]; ss += o1[q] * o1[q]; }
            ss = dpp_sum8(ss); const float inv = 1.f / fmaxf(sqrtf(ss), 1e-12f);
#pragma unroll
            for (int q = 0; q < 8; ++q) { o1[q] *= inv; o2[q] = o1[q] * a[q]; kr[q] = kr[q] * (1.f + (a[q] - 1.f) * kac[q]); }
            *(u32x4*)(PR + r * 512 + c0) = pack8(rr); *(u32x4*)(PK + r * 512 + c0) = pack8(kr); *(u32x4*)(PV + r * 512 + c0) = pack8(vr);
            *(u32x4*)(PKK + r * 512 + c0) = pack8(o1); *(u32x4*)(PBB + r * 512 + c0) = pack8(o2); }
    }
}

DI void phase_read(int tidx, int bidx, Params& p, int half) {
    const int wid = tidx >> 6, lane = tidx & 63;
    const bf16_t* Ub = (const bf16_t*)(p.ws + OFF_U); bf16_t* mix = (bf16_t*)(p.ws + OFF_ABF) + (size_t)half * MH * 1024;
    const bf16_t* PR = (const bf16_t*)(p.ws + OFF_PR); const bf16_t* PK = (const bf16_t*)(p.ws + OFF_PK); const bf16_t* PV = (const bf16_t*)(p.ws + OFF_PV); const bf16_t* PG = (const bf16_t*)(p.ws + OFF_PG);
    const int c0 = lane * 8;
    float gg[8], gb[8], rk[8], hn[8]; ld8f(p.rw_gn_g + c0, gg); ld8f(p.rw_gn_b + c0, gb); ld8f(p.rw_r_k + c0, rk); ld8f(p.hg_norm_g + (c0 & 127), hn);
    for (int r = bidx * 8 + wid; r < MH; r += gridDim.x * 8) {
        const bf16_t* ur = Ub + (size_t)r * 4608; const size_t o = (size_t)r * 512 + c0;
        float y0[8], y1[8], rr[8], kk[8], vv[8], g[8], o0[8], o1[8], hg[8];
        ld8bf_nt(ur + 1024 + c0, y0); ld8bf_nt(ur + 1536 + c0, y1); ld8bf_nt(PR + o, rr); ld8bf_nt(PK + o, kk); ld8bf_nt(PV + o, vv); ld8bf_nt(PG + o, g);
        ld8bf_nt(ur + c0, o0); ld8bf_nt(ur + 512 + c0, o1); ld8bf_nt(ur + 4096 + c0, hg);
        float s = 0.f, q = 0.f, d = 0.f;
#pragma unroll
        for (int k = 0; k < 8; ++k) { y0[k] += y1[k]; s += y0[k]; q += y0[k] * y0[k]; d += rr[k] * kk[k] * rk[k]; }
        s = dpp_sum8(s); q = dpp_sum8(q); d = dpp_sum8(d);
        const float mu = s * (1.f / 64.f); const float rs = rsqrtf(fmaxf(q * (1.f / 64.f) - mu * mu, 0.f) + 64e-5f);
#pragma unroll
        for (int k = 0; k < 8; ++k) y0[k] = ((y0[k] - mu) * rs * gg[k] + gb[k] + d * vv[k]) * g[k];
        *(u32x4*)(mix + (size_t)r * 1024 + c0) = pack8(y0);
        float ss = 0.f;
#pragma unroll
        for (int k = 0; k < 8; ++k) { o0[k] += o1[k]; ss += o0[k] * o0[k]; }
        ss = dpp_sum16(ss); const float rh = rsqrtf(ss * (1.f / 128.f) + 1e-5f);
#pragma unroll
        for (int k = 0; k < 8; ++k) o0[k] = o0[k] * rh * hn[k] * hg[k];
        *(u32x4*)(mix + (size_t)r * 1024 + 512 + c0) = pack8(o0);
    }
}

DI int attn_row(int b, int s) {
    const int hb = b >> 2, bl = b & 3; return s < 256 ? hb * MH + 16384 + bl * 256 + s : hb * MH + bl * 4096 + (s - 256);
}
DI void phase_attnprep(int tidx, int bidx, Params& p, bf16_t* lds) {
    const int tid = tidx, wid = tid >> 6, lane = tid & 63; bf16_t* U = (bf16_t*)(p.ws + OFF_U3); const float* rope = (const float*)(p.ws + OFF_ROPE);
    bf16_t* VT = (bf16_t*)(p.ws + OFF_VT);
    for (int unit = bidx; unit < 8 * 68 * 8; unit += gridDim.x) {
        const int h = unit & 7, st = (unit >> 3) % 68, b = unit / (68 * 8); const int s0 = st * 64; const int row0 = attn_row(b, s0);
        __syncthreads();
#pragma unroll
        for (int q = 0; q < 2; ++q) { const int i = tid + q * 512, tok = i >> 4, seg = i & 15;
            const u32x4 v = *(const u32x4*)(U + (size_t)(row0 + tok) * 3072 + 2048 + h * 128 + seg * 8);
            unsigned* d = (unsigned*)(lds + tok * 136 + seg * 8); d[0] = v.x; d[1] = v.y; d[2] = v.z; d[3] = v.w; }
        __syncthreads();
#pragma unroll
        for (int q = 0; q < 2; ++q) { const int i = tid + q * 512, e = i >> 3, seg = i & 7; const bf16_t* l = lds + ((seg >> 1) * 16 + (seg & 1) * 4) * 136 + e;
            u32x4 w; w.x = (unsigned)l[0] | ((unsigned)l[136] << 16); w.y = (unsigned)l[272] | ((unsigned)l[408] << 16); w.z = (unsigned)l[8 * 136] | ((unsigned)l[9 * 136] << 16); w.w = (unsigned)l[10 * 136] | ((unsigned)l[11 * 136] << 16);
            *(u32x4*)(VT + ((size_t)(b * 8 + h) * 128 + e) * 4352 + s0 + seg * 8) = w; }
    }
    __syncthreads();
    for (int lr = bidx * 8 + wid; lr < NLAT; lr += gridDim.x * 8) {
        const int b = lr >> 12, t = lr & 4095; bf16_t* ur = U + (size_t)attn_row(b, 256 + t) * 3072; const float* rp = rope + t * 64;
#pragma unroll
        for (int q = 0; q < 2; ++q) { const int it = q * 64 + lane; const int vec = it >> 2, bp = it & 3; const int blk = (bp & 1) + (bp >> 1) * 4;
            bf16_t* pl = ur + vec * 64 + blk * 8; const float* cp = rp + (blk >> 2) * 16 + (blk & 1) * 8;
            float xl[8], xh[8], cs[8], sn[8], ol[8], oh[8]; ld8bf(pl, xl); ld8bf(pl + 16, xh); ld8f(cp, cs); ld8f(cp + 32, sn);
            const float sc = vec < 16 ? QSCALE : 1.f;
#pragma unroll
            for (int k = 0; k < 8; ++k) { ol[k] = (xl[k] * cs[k] - xh[k] * sn[k]) * sc; oh[k] = (xh[k] * cs[k] + xl[k] * sn[k]) * sc; }
            *(u32x4*)pl = pack8(ol); *(u32x4*)(pl + 16) = pack8(oh); }
    }
}

DI void attn_tile(const char* kb, const char* vb, const bf16x8 (&qf)[4], f32x16 (&o)[4], float& mrun, float& lsum, const bool first, const int l31, const int hf) {
    bf16x8 ka[2][4], av[2];
#pragma unroll
    for (int k2 = 0; k2 < 2; ++k2)
#pragma unroll
        for (int dc = 0; dc < 4; ++dc) ka[k2][dc] = *(const bf16x8*)(kb + (k2 * 32 + l31) * 144 + dc * 32 + hf * 16);
    f32x16 s[2];
    __builtin_amdgcn_s_setprio(1);
#pragma unroll
    for (int k2 = 0; k2 < 2; ++k2) {
#pragma unroll
        for (int r = 0; r < 16; ++r) s[k2][r] = -mrun;
#pragma unroll
        for (int dc = 0; dc < 4; ++dc) s[k2] = MFMA32(ka[k2][dc], qf[dc], s[k2]);
    }
    __builtin_amdgcn_s_setprio(0);
#pragma unroll
    for (int v = 0; v < 2; ++v) av[v] = *(const bf16x8*)(vb + (v * 32 + l31) * 144 + hf * 16);
    float mx = s[0][0];
#pragma unroll
    for (int k2 = 0; k2 < 2; ++k2)
#pragma unroll
        for (int r = 0; r < 16; ++r) mx = fmaxf(mx, s[k2][r]);
    mx = fmaxf(mx, __shfl_xor(mx, 32, 64));
    if (first || __any(mx > 8.f)) {
        const float dm = first ? mx : fmaxf(mx, 0.f); const float fs = first ? 1.f : __builtin_amdgcn_exp2f(-dm); mrun += dm; lsum *= fs;
#pragma unroll
        for (int v = 0; v < 4; ++v)
#pragma unroll
            for (int r = 0; r < 16; ++r) o[v][r] *= fs;
#pragma unroll
        for (int k2 = 0; k2 < 2; ++k2)
#pragma unroll
            for (int r = 0; r < 16; ++r) s[k2][r] -= dm;
    }
    float ps = 0.f;
#pragma unroll
    for (int k2 = 0; k2 < 2; ++k2)
#pragma unroll
        for (int r = 0; r < 16; ++r) { const float e = __builtin_amdgcn_exp2f(s[k2][r]); s[k2][r] = e; ps += e; }
    lsum += ps;
    bf16x8 pf;
    __builtin_amdgcn_s_setprio(1);
#pragma unroll
    for (int hs = 0; hs < 8; ++hs) {
        const int idx = hs >> 1, vh = hs & 1, k2 = idx >> 1, st = idx & 1;
        bf16x8 an[2];
        if (hs < 7) { const int ni = (hs + 1) >> 1, nvh = (hs + 1) & 1;
#pragma unroll
            for (int v = 0; v < 2; ++v) an[v] = *(const bf16x8*)(vb + ((nvh * 2 + v) * 32 + l31) * 144 + (ni * 16 + hf * 8) * 2); }
        if (vh == 0) { u32x4 pw; pw.x = cvt_pk_bf16(s[k2][8 * st], s[k2][8 * st + 1]); pw.y = cvt_pk_bf16(s[k2][8 * st + 2], s[k2][8 * st + 3]);
            pw.z = cvt_pk_bf16(s[k2][8 * st + 4], s[k2][8 * st + 5]); pw.w = cvt_pk_bf16(s[k2][8 * st + 6], s[k2][8 * st + 7]); pf = __builtin_bit_cast(bf16x8, pw); }
#pragma unroll
        for (int v = 0; v < 2; ++v) o[vh * 2 + v] = MFMA32(av[v], pf, o[vh * 2 + v]);
        if (hs < 7) { av[0] = an[0]; av[1] = an[1]; }
    }
    __builtin_amdgcn_s_setprio(0);
}

DI void phase_attn(int tidx, int bidx, Params& p, char* ldsb) {
    const int tid = tidx, wid = tid >> 6, lane = tid & 63, l31 = lane & 31, hf = lane >> 5; const int m = wid & 1, qsub = wid >> 1;
    const bf16_t* U = (const bf16_t*)(p.ws + OFF_U3); const bf16_t* VT = (const bf16_t*)(p.ws + OFF_VT); bf16_t* mix = (bf16_t*)(p.ws + OFF_ABF);
    const float lam = ((const float*)(p.ws + OFF_MISC))[512];
    constexpr int KB = 2 * 64 * 144, VB = 128 * 144, TB = KB + VB;
    for (int item = bidx; item < 2048; item += gridDim.x) {
        const int qb = (item >> 3) & 31, h = item & 7, b = item >> 8;
        const int qrow = attn_row(b, 256 + qb * 128 + qsub * 32 + l31);
        bf16x8 qf[4];
#pragma unroll
        for (int dc = 0; dc < 4; ++dc) qf[dc] = *(const bf16x8*)(U + (size_t)qrow * 3072 + h * 128 + m * 64 + dc * 16 + hf * 8);
        f32x16 o[4];
#pragma unroll
        for (int v = 0; v < 4; ++v)
#pragma unroll
            for (int r = 0; r < 16; ++r) o[v][r] = 0.f;
        float mrun = 0.f, lsum = 0.f;
        u32x4 kA0, kA1, vA0, vA1;
        const bf16_t* vtb = VT + (size_t)(b * 8 + h) * 128 * 4352;
#define ATT_LOAD(j, S) do { { const int i = tid; k##S##0 = *(const u32x4*)(U + (size_t)attn_row(b, (j) * 64 + (i >> 4)) * 3072 + 1024 + h * 128 + (i & 15) * 8); v##S##0 = *(const u32x4*)(vtb + (size_t)(i >> 3) * 4352 + (j) * 64 + (i & 7) * 8); } \
            { const int i = tid + 512; k##S##1 = *(const u32x4*)(U + (size_t)attn_row(b, (j) * 64 + (i >> 4)) * 3072 + 1024 + h * 128 + (i & 15) * 8); v##S##1 = *(const u32x4*)(vtb + (size_t)(i >> 3) * 4352 + (j) * 64 + (i & 7) * 8); } } while (0)
#define ATT_STORE(bufi, S) do { char* base = ldsb + (bufi) * TB; { const int i = tid; const int seg = i & 15; *(u32x4*)(base + ((seg >> 3) * 64 + (i >> 4)) * 144 + (seg & 7) * 16) = k##S##0; *(u32x4*)(base + KB + (i >> 3) * 144 + (i & 7) * 16) = v##S##0; } \
            { const int i = tid + 512; const int seg = i & 15; *(u32x4*)(base + ((seg >> 3) * 64 + (i >> 4)) * 144 + (seg & 7) * 16) = k##S##1; *(u32x4*)(base + KB + (i >> 3) * 144 + (i & 7) * 16) = v##S##1; } } while (0)
        __syncthreads();
        ATT_LOAD(0, A); ATT_STORE(0, A);
        __syncthreads();
        for (int j = 0; j < 68; ++j) {
            { const int jn = j + 1 < 68 ? j + 1 : 67; ATT_LOAD(jn, A); }
            attn_tile(ldsb + (j & 1) * TB + m * (64 * 144), ldsb + (j & 1) * TB + KB, qf, o, mrun, lsum, j == 0, l31, hf);
            ATT_STORE((j + 1) & 1, A);
            lds_barrier();
        }
        const float linv = 1.f / (lsum + __shfl_xor(lsum, 32, 64));
        float* ex = (float*)ldsb + (size_t)qsub * 4096;
        if (m == 1) {
#pragma unroll
            for (int v = 0; v < 4; ++v)
#pragma unroll
                for (int r = 0; r < 16; ++r) ex[(v * 16 + r) * 64 + lane] = o[v][r] * linv;
        }
        __syncthreads();
        if (m == 0) {
            float ss = 0.f;
#pragma unroll
            for (int v = 0; v < 4; ++v)
#pragma unroll
                for (int r = 0; r < 16; ++r) { const float x = o[v][r] * linv - lam * ex[(v * 16 + r) * 64 + lane]; o[v][r] = x; ss += x * x; }
            ss += __shfl_xor(ss, 32, 64); const float rs = rsqrtf(ss * (1.f / 128.f) + 1e-5f) * (1.f - LAM_INIT);
            bf16_t* orow = mix + (size_t)qrow * 1024 + h * 128;
#pragma unroll
            for (int v = 0; v < 4; ++v)
#pragma unroll
                for (int g = 0; g < 4; ++g) { const int e = v * 32 + 8 * g + 4 * hf; const f32x4 ng = *(const f32x4*)(p.da_norm_g + e);
                    u32x2 w; w.x = cvt_pk_bf16(o[v][4 * g] * rs * ng[0], o[v][4 * g + 1] * rs * ng[1]); w.y = cvt_pk_bf16(o[v][4 * g + 2] * rs * ng[2], o[v][4 * g + 3] * rs * ng[3]);
                    *(u32x2*)(orow + e) = w; }
        }
    }
}

enum { K_PRE = 0, K_MODFIN, K_MODIN, K_SWIGLU, K_F32, K_BF16, K_POSTNORM, K_RWPREP, K_SCAN, K_READ, K_MIX, K_ATTN };
constexpr int NPHASE = 33;
#ifndef ENMASK
#define ENMASK 0xFFFF
#endif
#define EN(k) ((ENMASK >> (k)) & 1)
#ifndef REPMASK
#define REPMASK 0
#endif

__global__ __launch_bounds__(512, 2) void mega(ParamsS pv, int ph0, int ph1) {
    extern __shared__ __attribute__((aligned(16))) unsigned char shm[];
    cg::grid_group grid = cg::this_grid();
    __shared__ uint4 xb_words;
    if (threadIdx.x == 0) xb_words = make_uint4(0u, 0u, 0u, 0u);
    __syncthreads();
    XcdBarrier xb = xcd_barrier_post((unsigned*)(pv.ws + OFF_BAR), (volatile LAS unsigned*)&xb_words);
    for (int ph = ph0; ph < ph1; ++ph) {
        int kind = 0, layer = 0, j = 0, first = 0, nl = -1, nj = 0, skip = 0, half = 0, widx = 0; float wgt = 0.5f;
        switch (ph) {
            case 0: kind = K_PRE; break;
            case 1: kind = K_MODFIN; break;
            case 2: kind = K_MODIN; break;
            case 3: kind = K_SWIGLU; widx = 0; break;
            case 4: kind = K_F32; widx = 0; skip = 1; break;
            case 5: kind = K_MIX; widx = 0; layer = 0; j = 0; first = 1; nl = 0; nj = 1; break;
            case 6: kind = K_POSTNORM; layer = 0; j = 0; first = 1; nl = 0; nj = 1; skip = 2; break;
            case 7: kind = K_BF16; widx = 0; half = 0; break;
            case 8: kind = K_RWPREP; break;
            case 9: kind = K_SCAN; break;
            case 10: kind = K_READ; half = 0; break;
            case 11: kind = K_BF16; widx = 0; half = 1; break;
            case 12: kind = K_RWPREP; break;
            case 13: kind = K_SCAN; break;
            case 14: kind = K_READ; half = 1; break;
            case 15: kind = K_F32; widx = 4; skip = 1; break;
            case 16: kind = K_MIX; widx = 4; layer = 0; j = 1; wgt = 1.f; nl = 0; nj = 2; break;
            case 17: kind = K_POSTNORM; layer = 0; j = 1; wgt = 1.f; nl = 0; nj = 2; skip = 2; break;
            case 18: kind = K_SWIGLU; widx = 1; break;
            case 19: kind = K_F32; widx = 1; skip = 1; break;
            case 20: kind = K_MIX; widx = 1; layer = 0; j = 2; nl = 1; nj = 0; break;
            case 21: kind = K_POSTNORM; layer = 0; j = 2; nl = 1; nj = 0; skip = 2; break;
            case 22: kind = K_SWIGLU; widx = 2; break;
            case 23: kind = K_F32; widx = 2; skip = 1; break;
            case 24: kind = K_MIX; widx = 2; layer = 1; j = 0; nl = 1; nj = 1; break;
            case 25: kind = K_POSTNORM; layer = 1; j = 0; nl = 1; nj = 1; skip = 2; break;
            case 26: kind = K_BF16; widx = 1; break;
            case 27: kind = K_ATTN; break;
            case 28: kind = K_F32; widx = 5; skip = 1; break;
            case 29: kind = K_POSTNORM; layer = 1; j = 1; wgt = 1.f; nl = 1; nj = 2; skip = 1; break;
            case 30: kind = K_SWIGLU; widx = 3; skip = 1; break;
            case 31: kind = K_F32; widx = 3; skip = 1; break;
            default: kind = K_POSTNORM; layer = 1; j = 2; nl = -1; skip = 1; break;
        }
        for (int rep = 0; rep < 1 + ((REPMASK >> kind) & 1); ++rep) {
        if (rep) __syncthreads();
        const __attribute__((address_space(4))) char* ka = (const __attribute__((address_space(4))) char*)__builtin_amdgcn_kernarg_segment_ptr();
        asm volatile("" : "+s"(ka));
        Params& p = *(Params*)ka;
        int tidx = threadIdx.x; asm volatile("" : "+v"(tidx)); int bidx = blockIdx.x; asm volatile("" : "+s"(bidx));
        if (EN(K_SWIGLU) && kind == K_SWIGLU) {
            Gemm g; g.A = (const bf16_t*)(p.ws + OFF_ABF); g.Bt = (const bf16_t*)(p.ws + OFF_WFI + widx * SZ_WFI); g.M = skip ? NLAT : MROWS; g.N = 5632; g.K = 1024;
            Order S; S.init(g.M, g.N, (int)gridDim.x, bidx, skip); EpiSwiglu E; E.O = (bf16_t*)(p.ws + OFF_HID); E.ldc = FF;
            pg8::gemm_phase<EpiSwiglu, Order, false>(tidx, (PG8_LAS unsigned char*)shm, g, S, E, nullptr);
        } else if (EN(K_F32) && (kind == K_F32 || (kind == K_MIX && bidx < 32))) {
            const int mode = kind == K_MIX ? 2 : skip; const int G = kind == K_MIX ? 32 : (int)gridDim.x;
            Gemm g; g.M = mode == 2 ? 2048 : (mode == 1 ? NLAT : MROWS); g.N = 1024;
            if (widx < 4) { g.A = (const bf16_t*)(p.ws + OFF_HID); g.Bt = (const bf16_t*)(p.ws + OFF_WFO + widx * SZ_WFO); g.K = FF; }
            else { g.A = (const bf16_t*)(p.ws + OFF_ABF); g.Bt = (const bf16_t*)(p.ws + (widx == 4 ? OFF_WEO : OFF_WOO)); g.K = 1024; }
            Order S; S.init(g.M, g.N, G, bidx, mode); pg8::EpiBf16<0> E; E.O = (bf16_t*)(p.ws + OFF_OUTF); E.ldc = 1024; E.bias = nullptr; E.split_cols = 0; E.split_stride = 0;
            pg8::gemm_phase<pg8::EpiBf16<0>, Order, false>(tidx, (PG8_LAS unsigned char*)shm, g, S, E, nullptr);
        } else if (EN(K_BF16) && kind == K_BF16) {
            Gemm g; g.K = 1024;
            if (widx == 0) { g.A = (const bf16_t*)(p.ws + OFF_ABF) + (size_t)half * MH * 1024; g.Bt = (const bf16_t*)(p.ws + OFF_WEI); g.M = MH; g.N = 4608;
                EpiEven E; E.O = (bf16_t*)(p.ws + OFF_U); E.ldc = 4608; E.lb = (const float*)(p.ws + OFF_MISC);
                Order S; S.init(g.M, g.N, (int)gridDim.x, bidx, 0);
                pg8::gemm_phase<EpiEven, Order, false>(tidx, (PG8_LAS unsigned char*)shm, g, S, E, nullptr); }
            else { EpiOdd E; E.O = (bf16_t*)(p.ws + OFF_U3); E.VT = (bf16_t*)(p.ws + OFF_VT); E.rope = (const float*)(p.ws + OFF_ROPE);
                g.A = (const bf16_t*)(p.ws + OFF_ABF); g.Bt = (const bf16_t*)(p.ws + OFF_WOI); g.M = MROWS; g.N = 3072;
                Order S; S.init(g.M, g.N, (int)gridDim.x, bidx, 0);
                pg8::gemm_phase<EpiOdd, Order, false>(tidx, (PG8_LAS unsigned char*)shm, g, S, E, nullptr); }
        }
        else if (EN(K_PRE) && kind == K_PRE) phase_pre(tidx, bidx, p, (float*)shm);
        else if (EN(K_MODFIN) && kind == K_MODFIN) phase_modfin(tidx, bidx, p);
        else if (EN(K_MODIN) && kind == K_MODIN) phase_modin(tidx, bidx, p);
        else if (EN(K_POSTNORM) && kind == K_POSTNORM) phase_postnorm(tidx, bidx, p, layer, j, wgt, first, nl, nj, skip, 0, (int)gridDim.x);
        else if (EN(K_MIX) && kind == K_MIX) phase_postnorm(tidx, bidx, p, layer, j, wgt, first, nl, nj, 1, 32, (int)gridDim.x - 32);
        else if (EN(K_RWPREP) && kind == K_RWPREP) phase_rwprep(tidx, bidx, p, (char*)shm);
        else if (EN(K_SCAN) && kind == K_SCAN) phase_scan(tidx, bidx, p, (float*)shm);
        else if (EN(K_READ) && kind == K_READ) phase_read(tidx, bidx, p, half);
        else if (EN(K_ATTN)) phase_attn(tidx, bidx, p, (char*)shm);
        }
        if (ph + 1 < ph1) { if (ph1 < 0) grid.sync();
            xcd_barrier(xb); }
    }
}

extern "C" void kernel_launch(void* const* d_in, const int* in_sizes, int n_in, void* d_out, int out_size, void* d_ws, size_t ws_size, hipStream_t stream) {
    static int grid_blocks = 0;
    if (!grid_blocks) {
        hipFuncSetAttribute((const void*)mega, hipFuncAttributeMaxDynamicSharedMemorySize, LDS_BYTES);
        int dev = 0, cus = 0, per_cu = 0; hipGetDevice(&dev); hipDeviceGetAttribute(&cus, hipDeviceAttributeMultiprocessorCount, dev);
        hipOccupancyMaxActiveBlocksPerMultiprocessor(&per_cu, mega, 512, LDS_BYTES);
        if (per_cu < 1) per_cu = 1;
        grid_blocks = cus * 1;
        if (ws_size < WS_NEED) fprintf(stderr, "workspace too small: %zu < %zu\n", ws_size, (size_t)WS_NEED);
    }
    ParamsS p{};
    const float** f = (const float**)&p;
    for (int i = 0; i < 29; ++i) f[i] = (const float*)d_in[i];
    p.out = (float*)d_out; p.ws = (char*)d_ws;
    hipMemsetAsync((char*)d_ws + OFF_BAR, 0, 16384, stream);
#if COOP
    int ph0 = 0, ph1 = NPHASE; void* args[] = {&p, &ph0, &ph1};
    hipError_t e = hipLaunchCooperativeKernel((const void*)mega, dim3(grid_blocks), dim3(512), args, LDS_BYTES, stream);
    if (e != hipSuccess) fprintf(stderr, "cooperative launch failed: %s (grid %d)\n", hipGetErrorString(e), grid_blocks);
#else
    for (int ph = 0; ph < NPHASE; ++ph) mega<<<grid_blocks, 512, LDS_BYTES, stream>>>(p, ph, ph + 1);
#endif
}
```

```cpp
#include <hip/hip_runtime.h>
#include <hip/hip_cooperative_groups.h>
#include <hip/hip_fp16.h>
#include <cstdio>
namespace cg = cooperative_groups;
#ifndef COOP
#define COOP 1
#endif
#define DI __device__ __forceinline__
namespace pg8 {
#define PG8_LAS __attribute__((address_space(3)))
typedef unsigned short bf16_t;
typedef short bf16x8 __attribute__((ext_vector_type(8)));
typedef float f32x4 __attribute__((ext_vector_type(4)));
typedef unsigned u32x4 __attribute__((ext_vector_type(4)));
constexpr int BM = 256, BK = 64, HALF = 128, HTB = HALF * BK * 2  , STAGE_BYTES = 8 * HTB, NXCD = 8, WGM = 8;

__host__ __device__ __forceinline__ int lds_byte(int r, int c) { const int st = (r >> 4) * 2 + (c >> 5), rr = r & 15, cc = c & 31, ob = rr * 64 + cc * 2; return st * 1024 + (ob ^ (((ob >> 9) & 1) << 5)); }
__host__ __device__ __forceinline__ void stage_rc(int b, int& R, int& C) { const int st = b / 1024, sb = b % 1024, swz = sb ^ (((sb >> 9) & 1) << 5); R = (st >> 1) * 16 + swz / 64; C = (st & 1) * 32 + (swz % 64) / 2; }
__host__ __device__ __forceinline__ int perm32(int rho) { const int n = rho >> 4, i = rho & 15; return 8 * (i >> 2) + 4 * n + (i & 3); }

struct Unit { int pm, pn; };
struct Gemm { const bf16_t* A; const bf16_t* Bt; int M, N, K; };

__device__ __forceinline__ unsigned cvt_pk_bf16(float lo, float hi) { unsigned r; asm volatile("v_cvt_pk_bf16_f32 %0, %1, %2" : "=v"(r) : "v"(lo), "v"(hi)); return r; }
typedef float f32x2 __attribute__((ext_vector_type(2)));
__device__ __forceinline__ f32x2 gelu_pk(f32x2 v) {
    const f32x2 av = __builtin_elementwise_abs(v), d = av * 0.2316418882f + 1.0f;
    f32x2 t; t.x = __builtin_amdgcn_rcpf(d.x); t.y = __builtin_amdgcn_rcpf(d.y);
    f32x2 q = t * 0.5307027145f + (-0.7265760135f); q = q * t + 0.7107068705f; q = q * t + (-0.142248368f); q = q * t + 0.127414796f; q = q * t;
    const f32x2 s = (v * v) * (-0.72134752044f);
    f32x2 e; e.x = __builtin_amdgcn_exp2f(s.x); e.y = __builtin_amdgcn_exp2f(s.y);
    const f32x2 m = v * (q * e), r = v - m;
    f32x2 o; o.x = v.x < 0.f ? m.x : r.x; o.y = v.y < 0.f ? m.y : r.y; return o;
}

struct EpiF32 {
    static constexpr bool PERM = false, AFTER_DRAIN = false;
    float* C; int ldc; const float* bias;
    __device__ __forceinline__ void operator()(const f32x4 (&acc)[2][2][4][2], const Unit& u, int wr, int wc, int fr, int fq) const {
        const int row0 = u.pm * BM + wr * 64 + fr, col0 = u.pn * BM + wc * 32 + 4 * fq;
        f32x4 bv[2][2];
#pragma unroll
        for (int bj = 0; bj < 2; ++bj)
#pragma unroll
            for (int n = 0; n < 2; ++n) bv[bj][n] = bias ? *(const f32x4*)(bias + col0 + bj * HALF + n * 16) : (f32x4){0.f, 0.f, 0.f, 0.f};
#pragma unroll
        for (int ai = 0; ai < 2; ++ai)
#pragma unroll
            for (int m = 0; m < 4; ++m) { float* rowp = C + (size_t)(row0 + ai * HALF + m * 16) * ldc + col0;
#pragma unroll
                for (int bj = 0; bj < 2; ++bj)
#pragma unroll
                    for (int n = 0; n < 2; ++n) *(f32x4*)(rowp + bj * HALF + n * 16) = acc[ai][bj][m][n] + bv[bj][n]; }
    }
};
template <int ACT  > struct EpiBf16 {
    static constexpr bool PERM = true, AFTER_DRAIN = false;
    bf16_t* O; int ldc; const float* bias; int split_cols; size_t split_stride;
    __device__ __forceinline__ void operator()(const f32x4 (&acc)[2][2][4][2], const Unit& u, int wr, int wc, int fr, int fq) const {
        const int row0 = u.pm * BM + wr * 64 + fr; int colt = u.pn * BM; bf16_t* base = O;
        if (split_cols) { const int t = colt / split_cols; base += (size_t)t * split_stride; colt -= t * split_cols; }
        const int col0 = colt + wc * 32 + 8 * fq, bcol0 = u.pn * BM + wc * 32 + 8 * fq;
        f32x4 bv[2][2];
#pragma unroll
        for (int bj = 0; bj < 2; ++bj)
#pragma unroll
            for (int n = 0; n < 2; ++n) bv[bj][n] = bias ? *(const f32x4*)(bias + bcol0 + bj * HALF + 4 * n) : (f32x4){0.f, 0.f, 0.f, 0.f};
#pragma unroll
        for (int ai = 0; ai < 2; ++ai)
#pragma unroll
            for (int m = 0; m < 4; ++m) { bf16_t* rowp = base + (size_t)(row0 + ai * HALF + m * 16) * ldc + col0;
#pragma unroll
                for (int bj = 0; bj < 2; ++bj) { f32x4 v0 = acc[ai][bj][m][0] + bv[bj][0], v1 = acc[ai][bj][m][1] + bv[bj][1];
                    if (ACT == 1) { f32x2 a = gelu_pk((f32x2){v0[0], v0[1]}), b = gelu_pk((f32x2){v0[2], v0[3]}), c = gelu_pk((f32x2){v1[0], v1[1]}), d = gelu_pk((f32x2){v1[2], v1[3]});
                        v0 = (f32x4){a.x, a.y, b.x, b.y}; v1 = (f32x4){c.x, c.y, d.x, d.y}; }
                    if (ACT == 2) {
#pragma unroll
                        for (int j = 0; j < 4; ++j) { v0[j] = 0.5f * v0[j] * (1.0f + erff(v0[j] * 0.70710678f)); v1[j] = 0.5f * v1[j] * (1.0f + erff(v1[j] * 0.70710678f)); } }
                    u32x4 w; w.x = cvt_pk_bf16(v0[0], v0[1]); w.y = cvt_pk_bf16(v0[2], v0[3]); w.z = cvt_pk_bf16(v1[0], v1[1]); w.w = cvt_pk_bf16(v1[2], v1[3]);
                    *(u32x4*)(rowp + bj * HALF) = w; } }
    }
};

template <class Epi, class Sched, bool STAMP = false>
__device__ __forceinline__ void gemm_phase(int tidx, PG8_LAS unsigned char* lds, const Gemm g, const Sched& S, const Epi& E, unsigned long long* stamps) {
    const int tid = tidx, wid = __builtin_amdgcn_readfirstlane(tid >> 6), lane = tid & 63, wr = wid >> 2, wc = wid & 3, fr = lane & 15, fq = lane >> 4;
    const int K = g.K, nt = K / BK;
    int ts_lo = 0, ts_hi = 0, nts = 0; const unsigned long long rt_entry = STAMP ? (unsigned long long)wall_clock64() : 0ull;
#define PG8_STAMP() do { if (STAMP && wid == 0 && nts < 64) { const unsigned long long _c = (unsigned long long)clock64(); \
        ts_lo = (lane == nts) ? (int)(unsigned)_c : ts_lo; ts_hi = (lane == nts) ? (int)(unsigned)(_c >> 32) : ts_hi; ++nts; } } while (0)
    PG8_STAMP();
    unsigned voffA[2], voffB[2];
#pragma unroll
    for (int i = 0; i < 2; ++i) { int R, C; stage_rc(tid * 16 + i * 8192, R, C); const int Rb = Epi::PERM ? ((R & ~31) + perm32(R & 31)) : R;
        voffA[i] = (unsigned)(R * K + C) * 2u; voffB[i] = (unsigned)(Rb * K + C) * 2u; }
    const size_t kstep = (size_t)(BK * 2);
    const size_t hstep = (size_t)HALF * K * 2;
    const size_t tstep = 2 * hstep;
    const unsigned ldsw = (unsigned)wid * 1024u;
    const int aoff = lds_byte(wr * 64 + fr, fq * 8), boff = lds_byte(wc * 32 + fr, fq * 8);
#define PG8_SA(b, h) (((b) * 2 + (h)) * HTB)
#define PG8_SB(b, h) ((4 + (b) * 2 + (h)) * HTB)
#define PG8_STAGE(bufoff, gbase, voff) do { _Pragma("unroll") for (int _i = 0; _i < 2; ++_i) \
        __builtin_amdgcn_global_load_lds((const unsigned*)((const char*)(gbase) + (voff)[_i]), (PG8_LAS unsigned*)(lds + (bufoff) + ldsw + _i * 8192), 16, 0, 0); } while (0)
#define PG8_LDA(dst, b, h) do { _Pragma("unroll") for (int m = 0; m < 4; ++m) _Pragma("unroll") for (int k = 0; k < 2; ++k) dst[m][k] = *(const PG8_LAS bf16x8*)(lds + PG8_SA(b, h) + aoff + m * 2048 + k * 1024); } while (0)
#define PG8_LDB(dst, b, h) do { _Pragma("unroll") for (int n = 0; n < 2; ++n) _Pragma("unroll") for (int k = 0; k < 2; ++k) dst[n][k] = *(const PG8_LAS bf16x8*)(lds + PG8_SB(b, h) + boff + n * 2048 + k * 1024); } while (0)
#define PG8_MMA(ai, bj, At, Bt) do { __builtin_amdgcn_s_setprio(1); _Pragma("unroll") for (int m = 0; m < 4; ++m) _Pragma("unroll") for (int n = 0; n < 2; ++n) _Pragma("unroll") for (int k = 0; k < 2; ++k) \
        acc[ai][bj][m][n] = __builtin_amdgcn_mfma_f32_16x16x32_bf16(Bt[n][k], At[m][k], acc[ai][bj][m][n], 0, 0, 0); __builtin_amdgcn_s_setprio(0); } while (0)
#define PG8_WAIT_V(n) asm volatile("s_waitcnt vmcnt(" #n ")" ::: "memory")
#define PG8_WAIT_L(n) asm volatile("s_waitcnt lgkmcnt(" #n ")" ::: "memory")
#define PG8_BAR __builtin_amdgcn_s_barrier()
#define PG8_SCHED __builtin_amdgcn_sched_barrier(0)
    Unit cur, nxt; int ui = 0;
    if (!S.next(0, cur)) return;
    f32x4 acc[2][2][4][2];
#pragma unroll
    for (int a = 0; a < 2; ++a)
#pragma unroll
        for (int b = 0; b < 2; ++b)
#pragma unroll
            for (int m = 0; m < 4; ++m)
#pragma unroll
                for (int n = 0; n < 2; ++n) acc[a][b][m][n] = (f32x4){0.f, 0.f, 0.f, 0.f};
    bf16x8 At[4][2], B0[2][2], B1[2][2];
    const char* cA = (const char*)g.A + (size_t)cur.pm * tstep; const char* cB = (const char*)g.Bt + (size_t)cur.pn * tstep;
    S.a_ready(cur);
    PG8_STAGE(PG8_SB(0, 0), cB, voffB); PG8_STAGE(PG8_SA(0, 0), cA, voffA); PG8_STAGE(PG8_SB(0, 1), cB + hstep, voffB); PG8_STAGE(PG8_SA(0, 1), cA + hstep, voffA);
    if (wr == 1) PG8_BAR;
    PG8_WAIT_V(4); PG8_BAR;
    PG8_STAGE(PG8_SB(1, 0), cB + kstep, voffB); PG8_STAGE(PG8_SA(1, 0), cA + kstep, voffA); PG8_STAGE(PG8_SB(1, 1), cB + hstep + kstep, voffB);
    PG8_WAIT_V(6); PG8_BAR;
    PG8_STAMP();
    for (;;) {
        const bool has_next = S.next(ui + 1, nxt);
        const char* nA = has_next ? (const char*)g.A + (size_t)nxt.pm * tstep : cA; const char* nB = has_next ? (const char*)g.Bt + (size_t)nxt.pn * tstep : cB;
        for (int t = 0; t < nt; t += 2) {
            const bool last = (t == nt - 2);
            const char* a1 = cA + (size_t)(t + 1) * kstep;
            const char* a2 = last ? nA : cA + (size_t)(t + 2) * kstep; const char* b2 = last ? nB : cB + (size_t)(t + 2) * kstep;
            const char* a3 = a2 + kstep; const char* b3 = b2 + kstep;
            if (last && has_next) S.a_ready(nxt);
            PG8_LDB(B0, 0, 0); PG8_SCHED; PG8_LDA(At, 0, 0); PG8_STAGE(PG8_SA(1, 1), a1 + hstep, voffA);
            PG8_WAIT_L(8); PG8_BAR; PG8_WAIT_L(0); PG8_MMA(0, 0, At, B0); PG8_BAR; PG8_SCHED;
            PG8_LDB(B1, 0, 1); PG8_STAGE(PG8_SB(0, 0), b2, voffB);
            PG8_BAR; PG8_WAIT_L(0); PG8_MMA(0, 1, At, B1); PG8_BAR;
            PG8_LDA(At, 0, 1); PG8_STAGE(PG8_SA(0, 0), a2, voffA);
            PG8_BAR; PG8_WAIT_L(0); PG8_MMA(1, 0, At, B0); PG8_BAR; PG8_SCHED;
            PG8_STAGE(PG8_SB(0, 1), b2 + hstep, voffB);
            PG8_WAIT_V(6); PG8_BAR; PG8_MMA(1, 1, At, B1); PG8_BAR;
            PG8_LDB(B0, 1, 0); PG8_SCHED; PG8_LDA(At, 1, 0); PG8_STAGE(PG8_SA(0, 1), a2 + hstep, voffA);
            PG8_WAIT_L(8); PG8_BAR; PG8_WAIT_L(0); PG8_MMA(0, 0, At, B0); PG8_BAR; PG8_SCHED;
            PG8_LDB(B1, 1, 1); PG8_STAGE(PG8_SB(1, 0), b3, voffB);
            PG8_BAR; PG8_WAIT_L(0); PG8_MMA(0, 1, At, B1); PG8_BAR;
            PG8_LDA(At, 1, 1); PG8_STAGE(PG8_SA(1, 0), a3, voffA);
            PG8_BAR; PG8_WAIT_L(0); PG8_MMA(1, 0, At, B0); PG8_BAR; PG8_SCHED;
            PG8_STAGE(PG8_SB(1, 1), b3 + hstep, voffB);
            PG8_WAIT_V(6); PG8_BAR; PG8_MMA(1, 1, At, B1); PG8_BAR;
        }
        PG8_STAMP();
        if constexpr (!Epi::AFTER_DRAIN) { E(acc, cur, wr, wc, fr, fq); S.done(cur); }
        PG8_STAMP();
        if (!has_next) break;
#pragma unroll
        for (int a = 0; a < 2; ++a)
#pragma unroll
            for (int b = 0; b < 2; ++b)
#pragma unroll
                for (int m = 0; m < 4; ++m)
#pragma unroll
                    for (int n = 0; n < 2; ++n) acc[a][b][m][n] = (f32x4){0.f, 0.f, 0.f, 0.f};
        cur = nxt; cA = nA; cB = nB; ++ui;
    }
    PG8_WAIT_V(0);
    if (wr == 0) PG8_BAR;
    PG8_BAR;
    if constexpr (Epi::AFTER_DRAIN) { E.fused(acc, cur, wr, wc, fr, fq, lds, wid, lane); S.done(cur); }
    PG8_STAMP();
    if (STAMP && wid == 0) { stamps[lane] = lane < nts ? (((unsigned long long)(unsigned)ts_hi << 32) | (unsigned)ts_lo) : 0ull;
        if (lane == 62) stamps[62] = rt_entry; if (lane == 63) stamps[63] = (unsigned long long)wall_clock64(); }
#undef PG8_STAMP
#undef PG8_SA
#undef PG8_SB
#undef PG8_STAGE
#undef PG8_LDA
#undef PG8_LDB
#undef PG8_MMA
#undef PG8_WAIT_V
#undef PG8_WAIT_L
#undef PG8_BAR
#undef PG8_SCHED
}
}

#define XB_TMO      128
#define XB_XCNT(j)  (256  + 64 * (j))
#define XB_XSUB(j)  (1280 + 64 * (j))
#define XB_XGEN(j)  (2304 + 64 * (j))
#define XB_TOP      3328
#define XB_TOPGEN   3392
#define XCD_BAR_WORDS 3456
#define XB_SPIN_CAP (1u << 22)
#define LAS __attribute__((address_space(3)))

__device__ __forceinline__ unsigned xb_ld(unsigned* p)              { return __hip_atomic_load(p, __ATOMIC_RELAXED, __HIP_MEMORY_SCOPE_AGENT); }
__device__ __forceinline__ unsigned xb_add(unsigned* p, unsigned v) { return __hip_atomic_fetch_add(p, v, __ATOMIC_RELAXED, __HIP_MEMORY_SCOPE_AGENT); }
__device__ __forceinline__ unsigned xb_xcc_id() { return (unsigned)__builtin_amdgcn_s_getreg((3 << 11) | 20) & 0xFu; }
#define XB_SPIN(cond, bar) do { unsigned _sp = 0; while (cond) { __builtin_amdgcn_s_sleep(1); \
    if ((++_sp & 255u) == 0u) { if (xb_ld(&(bar)[XB_TMO])) break; if (_sp > XB_SPIN_CAP) { atomicAdd(&(bar)[XB_TMO], 1u); break; } } } } while (0)

struct XcdBarrier {
    unsigned* bar; unsigned x;
    volatile LAS unsigned* st;
};

__device__ __forceinline__ XcdBarrier xcd_barrier_post(unsigned* bar, volatile LAS unsigned* st) {
    XcdBarrier b; b.bar = bar; b.x = xb_xcc_id(); b.st = st;
    if (threadIdx.x == 0) (void)xb_add(&bar[XB_XCNT(b.x)], 1u);
    return b;
}
__device__ __forceinline__ void xcd_barrier_complete(unsigned* bar, unsigned x, unsigned& nloc, unsigned& nx) {
    const unsigned G = gridDim.x * gridDim.y * gridDim.z;
    unsigned sum, cnt, mine, sp = 0u;
    for (;;) {
        sum = 0u; cnt = 0u; mine = 0u;
#pragma unroll
        for (unsigned j = 0; j < 16; ++j) { const unsigned c = xb_ld(&bar[XB_XCNT(j)]); sum += c; cnt += (c > 0u) ? 1u : 0u; mine = (j == x) ? c : mine; }
        if (sum == G) break;
        __builtin_amdgcn_s_sleep(1);
        if ((++sp & 255u) == 0u) { if (xb_ld(&bar[XB_TMO])) break; if (sp > XB_SPIN_CAP) { atomicAdd(&bar[XB_TMO], 1u); break; } }
    }
    nloc = mine > 0u ? mine : 1u; nx = cnt > 0u ? cnt : 1u;
}

__device__ __forceinline__ void xcd_barrier(const XcdBarrier& b) {
    asm volatile("s_waitcnt vmcnt(0)" ::: "memory");
    __syncthreads();
    if (threadIdx.x == 0) {
        unsigned* bar = b.bar;
        __builtin_amdgcn_s_waitcnt(0);
        unsigned nloc = b.st[0], nx = b.st[1];
        if (nloc == 0u) { xcd_barrier_complete(bar, b.x, nloc, nx); b.st[0] = nloc; b.st[1] = nx; }
        const unsigned old = xb_add(&bar[XB_XSUB(b.x)], 1u);
        const unsigned gen = old / nloc;
        if (old + 1u == (gen + 1u) * nloc) {
            __builtin_amdgcn_fence(__ATOMIC_RELEASE, "agent");
            asm volatile("s_waitcnt vmcnt(0)" ::: "memory");
            const unsigned og = xb_add(&bar[XB_TOP], 1u);
            const unsigned tg = og / nx;
            if (og + 1u == (tg + 1u) * nx) xb_add(&bar[XB_TOPGEN], 1u);
            else XB_SPIN(xb_ld(&bar[XB_TOPGEN]) == tg, bar);
            __builtin_amdgcn_fence(__ATOMIC_ACQUIRE, "agent");
            xb_add(&bar[XB_XGEN(b.x)], 1u);
            asm volatile("s_waitcnt vmcnt(0)" ::: "memory");
        } else {
            XB_SPIN(xb_ld(&bar[XB_XGEN(b.x)]) == gen, bar);
            __builtin_amdgcn_fence(__ATOMIC_ACQUIRE, "agent");
            asm volatile("s_waitcnt vmcnt(0)" ::: "memory");
        }
    }
    __syncthreads();
}

using pg8::bf16_t; using pg8::bf16x8; using pg8::f32x4; using pg8::u32x4; using pg8::Unit; using pg8::Gemm; using pg8::cvt_pk_bf16;
typedef float f32x16 __attribute__((ext_vector_type(16)));
typedef unsigned u32x2 __attribute__((ext_vector_type(2)));

constexpr int DM = 1024, FF = 2816, MROWS = 34816, MH = 17408, NLAT = 32768;
constexpr float ALPHA = 1.4142135623730951f;
constexpr float LAM_INIT = 0.35550907f;
constexpr float QSCALE = 0.18033688011112042f;
constexpr int LDS_BYTES = 131072;

constexpr size_t SZ_WFI = (size_t)5632 * 1024 * 2, SZ_WFO = (size_t)1024 * 2816 * 2;
constexpr size_t OFF_WFI = 0;
constexpr size_t OFF_WFO = OFF_WFI + 4 * SZ_WFI;
constexpr size_t OFF_WEI = OFF_WFO + 4 * SZ_WFO;
constexpr size_t OFF_WEO = OFF_WEI + (size_t)4608 * 1024 * 2;
constexpr size_t OFF_WOI = OFF_WEO + (size_t)1024 * 1024 * 2;
constexpr size_t OFF_WOO = OFF_WOI + (size_t)3072 * 1024 * 2;
constexpr size_t OFF_HCTX = OFF_WOO + (size_t)1024 * 1024 * 2;
constexpr size_t OFF_MODP = OFF_HCTX + (size_t)2048 * 1024 * 4;
constexpr size_t OFF_MODV = OFF_MODP + (size_t)32 * 2 * 9 * 9216 * 4;
constexpr size_t OFF_ROPE = OFF_MODV + (size_t)2 * 9 * 9216 * 4;
constexpr size_t OFF_MISC = OFF_ROPE + (size_t)4096 * 64 * 4;
constexpr size_t OFF_BAR = OFF_MISC + 4096;
constexpr size_t OFF_LW = OFF_BAR + 16384;
constexpr size_t OFF_ABF = OFF_LW + 368640;
constexpr size_t OFF_BIG = OFF_ABF + (size_t)MROWS * 1024 * 2;
constexpr size_t OFF_HID = OFF_BIG;
constexpr size_t OFF_OUTF = OFF_BIG + (size_t)MROWS * FF * 2;
constexpr size_t WS_NEED = OFF_OUTF + (size_t)MROWS * 1024 * 4;
constexpr size_t SZ_PU = (size_t)MH * 512 * 2;
constexpr size_t OFF_U = OFF_BIG;
constexpr size_t OFF_PR = OFF_U + (size_t)MH * 4608 * 2;
constexpr size_t OFF_PK = OFF_PR + SZ_PU, OFF_PV = OFF_PK + SZ_PU, OFF_PKK = OFF_PV + SZ_PU, OFF_PBB = OFF_PKK + SZ_PU;
constexpr size_t OFF_PEW = OFF_PBB + SZ_PU;
constexpr size_t OFF_PG = OFF_PEW + 2 * SZ_PU;
constexpr size_t OFF_Y0 = OFF_PG + SZ_PU, OFF_Y1 = OFF_Y0 + SZ_PU;
constexpr size_t OFF_O0 = OFF_PR, OFF_O1 = OFF_PK;
constexpr size_t OFF_U3 = OFF_BIG;
constexpr size_t OFF_VT = OFF_U3 + (size_t)MROWS * 3072 * 2;

struct ParamsS {
    const float *x, *c, *ctx, *cctx, *w_mod, *b_mod, *ln_g, *ln_b, *ffn_w_in, *ffn_w_out, *ev_w_in, *ev_w_out, *rw_mu, *rw_w0, *rw_w2, *rw_a0, *rw_a2, *rw_g2,
        *rw_k_k, *rw_k_a, *rw_r_k, *rw_gn_g, *rw_gn_b, *hg_lb, *hg_norm_g, *od_w_in, *od_w_out, *da_lambda, *da_norm_g;
    float* out;
    char* ws;
};
typedef const __attribute__((address_space(4))) ParamsS Params;

DI float bf2f(bf16_t v) { return __uint_as_float((unsigned)v << 16); }
DI bf16_t f2bf(float f) { unsigned u = __float_as_uint(f); u += 0x7FFFu + ((u >> 16) & 1u); return (bf16_t)(u >> 16); }
DI float lo2f(unsigned w) { return __uint_as_float(w << 16); }
DI float hi2f(unsigned w) { return __uint_as_float(w & 0xFFFF0000u); }
DI float sigmoidf_(float x) { return __builtin_amdgcn_rcpf(1.f + __builtin_amdgcn_exp2f(-1.4426950408889634f * x)); }
DI float dpp_sum16(float x) {
    x += __int_as_float(__builtin_amdgcn_update_dpp(0, __float_as_int(x), 0xB1, 0xF, 0xF, true));
    x += __int_as_float(__builtin_amdgcn_update_dpp(0, __float_as_int(x), 0x4E, 0xF, 0xF, true));
    x += __int_as_float(__builtin_amdgcn_update_dpp(0, __float_as_int(x), 0x141, 0xF, 0xF, true));
    x += __int_as_float(__builtin_amdgcn_update_dpp(0, __float_as_int(x), 0x140, 0xF, 0xF, true));
    return x;
}
DI float wave_sum(float v) {
    v = dpp_sum16(v);
    v += __int_as_float(__builtin_amdgcn_update_dpp(0, __float_as_int(v), 0x142, 0xA, 0xF, false));
    v += __int_as_float(__builtin_amdgcn_update_dpp(0, __float_as_int(v), 0x143, 0xC, 0xF, false));
    return __int_as_float(__builtin_amdgcn_readlane(__float_as_int(v), 63));
}
DI void lds_barrier() { asm volatile("s_waitcnt lgkmcnt(0)" ::: "memory"); __builtin_amdgcn_s_barrier(); asm volatile("" ::: "memory"); }
DI void row_info(int rho, int& b, int& t, int& isctx) {
    const int half = rho >= MH ? 1 : 0; int q = rho - half * MH;
    if (q < 16384) { isctx = 0; b = half * 4 + (q >> 12); t = q & 4095; }
    else { q -= 16384; isctx = 1; b = half * 4 + (q >> 8); t = q & 255; }
}
DI float* h_ptr(Params& p, int b, int t, int isctx) {
    return isctx ? (float*)(p.ws + OFF_HCTX) + ((size_t)b * 256 + t) * 1024 : p.out + ((size_t)b * 4096 + t) * 1024;
}
DI const float* in_ptr(Params& p, int b, int t, int isctx) {
    return isctx ? p.ctx + ((size_t)b * 256 + t) * 1024 : p.x + ((size_t)b * 4096 + t) * 1024;
}

struct Order {
    int nM, nN, nwg, G, c, skipctx;
    DI void init(int M, int N, int G_, int c_, int skip) { nM = M / 256; nN = N / 256; nwg = nM * nN; G = G_; c = c_; skipctx = skip; }
    DI bool next(int i, Unit& u) const {
        const long L = (long)i * G + c; if (L >= nwg) return false;
        int wgid = (int)L; { const int q = nwg / 8, r = nwg % 8, xcd = wgid % 8, off = wgid / 8; wgid = (xcd < r ? xcd * (q + 1) : r * (q + 1) + (xcd - r) * q) + off; }
        const int nig = 8 * nN, gid = wgid / nig, fm = gid * 8, gsz = (nM - fm) < 8 ? (nM - fm) : 8;
        u.pm = fm + ((wgid % nig) % gsz); u.pn = (wgid % nig) / gsz;
        if (skipctx == 1) u.pm += 4 * (u.pm >> 6);
        else if (skipctx == 2) u.pm = 64 + (u.pm & 3) + 68 * (u.pm >> 2);
        return true;
    }
    DI void a_ready(const Unit&) const {}
    DI void done(const Unit&) const {}
};

struct EpiSwiglu {
    static constexpr bool PERM = true, AFTER_DRAIN = false;
    bf16_t* O; int ldc;
    DI void operator()(const f32x4 (&acc)[2][2][4][2], const Unit& u, int wr, int wc, int fr, int fq) const {
        const int row0 = u.pm * 256 + wr * 64 + fr; const int col0 = (u.pn * 256 + wc * 32 + 8 * fq) >> 1;
#pragma unroll
        for (int ai = 0; ai < 2; ++ai)
#pragma unroll
            for (int m = 0; m < 4; ++m) { bf16_t* rowp = O + (size_t)(row0 + ai * 128 + m * 16) * ldc + col0;
#pragma unroll
                for (int bj = 0; bj < 2; ++bj) { const f32x4 v0 = acc[ai][bj][m][0], v1 = acc[ai][bj][m][1];
                    const float h0 = v0[0] * sigmoidf_(v0[0]) * v0[1], h1 = v0[2] * sigmoidf_(v0[2]) * v0[3];
                    const float h2 = v1[0] * sigmoidf_(v1[0]) * v1[1], h3 = v1[2] * sigmoidf_(v1[2]) * v1[3];
                    u32x2 w; w.x = cvt_pk_bf16(h0, h1); w.y = cvt_pk_bf16(h2, h3);
                    *(u32x2*)(rowp + bj * 64) = w; } }
    }
};

struct EpiEven {
    static constexpr bool PERM = true, AFTER_DRAIN = false;
    bf16_t* O; int ldc; const float* lb;
    DI void operator()(const f32x4 (&acc)[2][2][4][2], const Unit& u, int wr, int wc, int fr, int fq) const {
        const int row0 = u.pm * 256 + wr * 64 + fr; const int col0 = u.pn * 256 + wc * 32 + 8 * fq;
        const int cls = u.pn < 8 ? 0 : (u.pn < 10 ? 1 : (u.pn < 14 ? 2 : (u.pn < 16 ? 0 : 1)));
        f32x4 om[2][2];
#pragma unroll
        for (int bj = 0; bj < 2; ++bj)
#pragma unroll
            for (int n = 0; n < 2; ++n) { om[bj][n] = (f32x4){1.f, 1.f, 1.f, 1.f}; if (cls == 2) om[bj][n] = om[bj][n] - *(const f32x4*)(lb + ((col0 + bj * 128 + 4 * n - 2560) & 511)); }
#pragma unroll
        for (int ai = 0; ai < 2; ++ai)
#pragma unroll
            for (int m = 0; m < 4; ++m) { bf16_t* rowp = O + (size_t)(row0 + ai * 128 + m * 16) * ldc + col0;
#pragma unroll
                for (int bj = 0; bj < 2; ++bj) { f32x4 v0 = acc[ai][bj][m][0], v1 = acc[ai][bj][m][1];
                    if (cls == 1) {
#pragma unroll
                        for (int i = 0; i < 4; ++i) { v0[i] = v0[i] * sigmoidf_(v0[i]); v1[i] = v1[i] * sigmoidf_(v1[i]); } }
                    else if (cls == 2) {
#pragma unroll
                        for (int i = 0; i < 4; ++i) { v0[i] = om[bj][0][i] * sigmoidf_(-v0[i]); v1[i] = om[bj][1][i] * sigmoidf_(-v1[i]); } }
                    u32x4 w; w.x = cvt_pk_bf16(v0[0], v0[1]); w.y = cvt_pk_bf16(v0[2], v0[3]); w.z = cvt_pk_bf16(v1[0], v1[1]); w.w = cvt_pk_bf16(v1[2], v1[3]);
                    *(u32x4*)(rowp + bj * 128) = w; } }
    }
};

struct EpiOdd {
    static constexpr bool PERM = true, AFTER_DRAIN = false;
    bf16_t* O; bf16_t* VT; const float* rope;
    DI void operator()(const f32x4 (&acc)[2][2][4][2], const Unit& u, int wr, int wc, int fr, int fq) const {
        const int col0 = u.pn * 256 + wc * 32 + 8 * fq;
#pragma unroll
        for (int ai = 0; ai < 2; ++ai)
#pragma unroll
            for (int m = 0; m < 4; ++m) { const int rho = u.pm * 256 + wr * 64 + fr + ai * 128 + m * 16; int b, t, ic; row_info(rho, b, t, ic);
                if (u.pn < 8) { bf16_t* rowp = O + (size_t)rho * 3072 + col0; const float* tab = rope + t * 64; const float sc = u.pn < 4 ? QSCALE : 1.f;
#pragma unroll
                    for (int bj = 0; bj < 2; ++bj) { f32x4 v0 = acc[ai][bj][m][0], v1 = acc[ai][bj][m][1];
                        if (!ic) { const int cc = (col0 + bj * 128) & 63; const int ti = (cc >> 5) * 16 + ((cc & 31) >> 1); const f32x4 cs = *(const f32x4*)(tab + ti), sn = *(const f32x4*)(tab + 32 + ti);
                            const f32x4 r0 = {v0[0] * cs[0] - v0[1] * sn[0], v0[1] * cs[0] + v0[0] * sn[0], v0[2] * cs[1] - v0[3] * sn[1], v0[3] * cs[1] + v0[2] * sn[1]};
                            const f32x4 r1 = {v1[0] * cs[2] - v1[1] * sn[2], v1[1] * cs[2] + v1[0] * sn[2], v1[2] * cs[3] - v1[3] * sn[3], v1[3] * cs[3] + v1[2] * sn[3]};
                            v0 = r0; v1 = r1; }
                        v0 = v0 * sc; v1 = v1 * sc;
                        u32x4 w; w.x = cvt_pk_bf16(v0[0], v0[1]); w.y = cvt_pk_bf16(v0[2], v0[3]); w.z = cvt_pk_bf16(v1[0], v1[1]); w.w = cvt_pk_bf16(v1[2], v1[3]);
                        *(u32x4*)(rowp + bj * 128) = w; }
                } else { const int s = ic ? t : 256 + t; const int kk = s & 15; const int pos = (s & ~15) | (kk < 4 ? kk : (kk < 8 ? kk + 4 : (kk < 12 ? kk - 4 : kk)));
#pragma unroll
                    for (int bj = 0; bj < 2; ++bj) { const int cv = col0 + bj * 128 - 2048; bf16_t* vp = VT + ((size_t)(b * 8 + (cv >> 7)) * 128 + (cv & 127)) * 4352 + pos;
                        const f32x4 v0 = acc[ai][bj][m][0], v1 = acc[ai][bj][m][1];
                        vp[0] = f2bf(v0[0]); vp[4352] = f2bf(v0[1]); vp[2 * 4352] = f2bf(v0[2]); vp[3 * 4352] = f2bf(v0[3]);
                        vp[4 * 4352] = f2bf(v1[0]); vp[5 * 4352] = f2bf(v1[1]); vp[6 * 4352] = f2bf(v1[2]); vp[7 * 4352] = f2bf(v1[3]); }
                }
            }
    }
};

DI void conv_tile(int tidx, const float* src, int Nsrc, int K, bf16_t* dst, int kind, int tile, float* lds) {
    const int nkt = K >> 8; const int nt = tile / nkt, kt = tile - nt * nkt; const int n0 = nt * 64, k0 = kt * 256;
    const int nn = tidx & 63, kq = tidx >> 6; const int n = n0 + nn; int col;
    if (kind == 1) col = (n & 1) ? (FF + (n >> 1)) : (n >> 1);
    else if (kind == 2) col = n < 1888 ? n : (n < 2048 ? -1 : n - 160);
    else if (kind == 3) { if (n < 2048) { const int pp = n & 63, q = pp & 31; col = (n & ~63) + (pp & 32) + (q >> 1) + 16 * (q & 1); } else col = n; }
    else col = n;
    __syncthreads();
#pragma unroll
    for (int hh = 0; hh < 2; ++hh) { float v[16];
#pragma unroll
        for (int i = 0; i < 16; ++i) v[i] = col >= 0 ? __builtin_nontemporal_load(src + (size_t)(k0 + kq + 8 * (hh * 16 + i)) * Nsrc + col) : 0.f;
#pragma unroll
        for (int i = 0; i < 16; ++i) lds[(kq + 8 * (hh * 16 + i)) * 65 + nn] = v[i]; }
    __syncthreads();
    const int n2 = tidx >> 3, ks = tidx & 7;
#pragma unroll
    for (int j = 0; j < 4; ++j) { const float* l = lds + (j * 64 + ks * 8) * 65 + n2;
        u32x4 w; w.x = cvt_pk_bf16(l[0], l[65]); w.y = cvt_pk_bf16(l[130], l[195]); w.z = cvt_pk_bf16(l[260], l[325]); w.w = cvt_pk_bf16(l[390], l[455]);
        *(u32x4*)(dst + (size_t)(n0 + n2) * K + k0 + j * 64 + ks * 8) = w; }
}

DI void phase_pre(int tidx, int bidx, Params& p, float* lds) {
    const int tid = tidx;
    float* part = (float*)(p.ws + OFF_MODP);
    for (int u = bidx; u < 1152; u += gridDim.x) {
        const int ks = u & 31, ct = (u >> 5) % 18, layer = u / 576;
        __syncthreads();
        for (int i = tid; i < 9 * 32; i += 512) { const int r = i >> 5, k = i & 31; const float cv = r < 8 ? p.c[r * 1024 + ks * 32 + k] : p.cctx[ks * 32 + k]; lds[i] = cv * sigmoidf_(cv); }
        __syncthreads();
        const int col = ct * 512 + tid; const float* w = p.w_mod + ((size_t)layer * 1024 + ks * 32) * 9216 + col;
        float a0 = 0, a1 = 0, a2 = 0, a3 = 0, a4 = 0, a5 = 0, a6 = 0, a7 = 0, a8 = 0;
#pragma unroll 8
        for (int k = 0; k < 32; ++k) { const float wv = __builtin_nontemporal_load(w + (size_t)k * 9216);
            a0 += lds[k] * wv; a1 += lds[32 + k] * wv; a2 += lds[64 + k] * wv; a3 += lds[96 + k] * wv; a4 += lds[128 + k] * wv; a5 += lds[160 + k] * wv; a6 += lds[192 + k] * wv; a7 += lds[224 + k] * wv; a8 += lds[256 + k] * wv; }
        float* o = part + ((size_t)(ks * 2 + layer) * 9) * 9216 + col;
        o[0] = a0; o[9216] = a1; o[2 * 9216] = a2; o[3 * 9216] = a3; o[4 * 9216] = a4; o[5 * 9216] = a5; o[6 * 9216] = a6; o[7 * 9216] = a7; o[8 * 9216] = a8;
    }
    for (int tI = bidx; tI < 2720; tI += gridDim.x) {
        if (tI < 1408) { const int w = tI / 352; conv_tile(tidx, p.ffn_w_in + (size_t)w * 1024 * 5632, 5632, 1024, (bf16_t*)(p.ws + OFF_WFI + w * SZ_WFI), 1, tI - w * 352, lds); }
        else if (tI < 2112) { const int q = tI - 1408, w = q / 176; conv_tile(tidx, p.ffn_w_out + (size_t)w * 2816 * 1024, 1024, 2816, (bf16_t*)(p.ws + OFF_WFO + w * SZ_WFO), 0, q - w * 176, lds); }
        else if (tI < 2400) conv_tile(tidx, p.ev_w_in, 4448, 1024, (bf16_t*)(p.ws + OFF_WEI), 2, tI - 2112, lds);
        else if (tI < 2464) conv_tile(tidx, p.ev_w_out, 1024, 1024, (bf16_t*)(p.ws + OFF_WEO), 0, tI - 2400, lds);
        else if (tI < 2656) conv_tile(tidx, p.od_w_in, 3072, 1024, (bf16_t*)(p.ws + OFF_WOI), 3, tI - 2464, lds);
        else conv_tile(tidx, p.od_w_out, 1024, 1024, (bf16_t*)(p.ws + OFF_WOO), 0, tI - 2656, lds);
    }
    { bf16_t* LW = (bf16_t*)(p.ws + OFF_LW);
      for (int i = bidx * 512 + tid; i < 512 * 352; i += gridDim.x * 512) {
          if (i < 32768) { const int c = i >> 6, k = i & 63; LW[i] = f2bf(p.rw_a2[k * 512 + c]); }
          else if (i < 98304) { const int q = i - 32768; const int d = q >> 15, c = (q >> 6) & 511, k = q & 63; LW[i] = f2bf(p.rw_w2[(d * 64 + k) * 512 + c]); }
          else { const int q = i - 98304; const int c = q / 160, k = q - c * 160; LW[i] = f2bf(p.rw_g2[k * 512 + c]); } } }
    float* rope = (float*)(p.ws + OFF_ROPE);
    for (int i = bidx * 512 + tid; i < 4096 * 32; i += gridDim.x * 512) {
        const int t = i >> 5, f = i & 31; const float pos = (float)((f < 16) ? (t >> 6) : (t & 63));
        const float inv = exp2f(-(float)(f & 15) * 0.8304820237218406f); const float ang = pos * inv;
        rope[t * 64 + f] = cosf(ang); rope[t * 64 + 32 + f] = sinf(ang);
    }
    if (bidx == 0) {
        float* misc = (float*)(p.ws + OFF_MISC);
        { const float l0 = p.hg_lb[tid], l1 = p.hg_lb[512 + tid], l2 = p.hg_lb[1024 + tid]; const float mx = fmaxf(l0, fmaxf(l1, l2));
          const float e0 = expf(l0 - mx), e1 = expf(l1 - mx), e2 = expf(l2 - mx); misc[tid] = e0 / (e0 + e1 + e2); }
        if (tid < 64) { const float s01 = wave_sum(p.da_lambda[tid] * p.da_lambda[64 + tid]); const float s23 = wave_sum(p.da_lambda[128 + tid] * p.da_lambda[192 + tid]);
            if (tid == 0) misc[512] = expf(s01) - expf(s23) + LAM_INIT; }
    }
}

DI void phase_modfin(int tidx, int bidx, Params& p) {
    const float* part = (const float*)(p.ws + OFF_MODP); float* mv = (float*)(p.ws + OFF_MODV);
    for (int i = bidx * 512 + tidx; i < 2 * 9 * 9216; i += gridDim.x * 512) {
        const int layer = i / (9 * 9216); const int col = i % 9216; float s = p.b_mod[layer * 9216 + col];
#pragma unroll 8
        for (int ks = 0; ks < 32; ++ks) s += part[(size_t)ks * 2 * 9 * 9216 + i];
        mv[i] = s;
    }
}

DI void phase_modin(int tidx, int bidx, Params& p) {
    const int wid = tidx >> 6, lane = tidx & 63; const float* mv = (const float*)(p.ws + OFF_MODV); bf16_t* abf = (bf16_t*)(p.ws + OFF_ABF);
    for (int rho = bidx * 8 + wid; rho < MROWS; rho += gridDim.x * 8) {
        int b, t, ic; row_info(rho, b, t, ic); const float* src = in_ptr(p, b, t, ic); const float* m = mv + (size_t)(ic ? 8 : b) * 9216;
#pragma unroll
        for (int i = 0; i < 4; ++i) { const int d = i * 256 + lane * 4; const f32x4 h = __builtin_nontemporal_load((const f32x4*)(src + d)), sh = *(const f32x4*)(m + d), sc = *(const f32x4*)(m + 1024 + d);
            u32x2 w; w.x = cvt_pk_bf16(h[0] * (1.f + sc[0]) + sh[0], h[1] * (1.f + sc[1]) + sh[1]); w.y = cvt_pk_bf16(h[2] * (1.f + sc[2]) + sh[2], h[3] * (1.f + sc[3]) + sh[3]);
            *(u32x2*)(abf + (size_t)rho * 1024 + d) = w; }
    }
}

DI void phase_postnorm(int tidx, int bidx, Params& p, int layer, int j, float wgt, int first, int nl, int nj, int rowmode, int wg0, int nwg) {
    const int wid = tidx >> 6, lane = tidx & 63; const float* mv = (const float*)(p.ws + OFF_MODV); bf16_t* abf = (bf16_t*)(p.ws + OFF_ABF);
    const bf16_t* outf = (const bf16_t*)(p.ws + OFF_OUTF); const float* lg = p.ln_g + (layer * 3 + j) * 1024; const float* lb = p.ln_b + (layer * 3 + j) * 1024;
    const int stride = nwg * 8; const int nrows = rowmode == 0 ? MROWS : (rowmode == 1 ? NLAT : 2048);
    f32x4 lgv[4], lbv[4];
#pragma unroll
    for (int i = 0; i < 4; ++i) { lgv[i] = *(const f32x4*)(lg + i * 256 + lane * 4); lbv[i] = *(const f32x4*)(lb + i * 256 + lane * 4); }
    for (int idx0 = (bidx - wg0) * 8 + wid; idx0 < nrows; idx0 += 2 * stride) {
        f32x4 v[2][4], shv[2][4], scv[2][4]; float s[2], q[2]; float* hd[2]; const float* m2[2]; bool ok[2]; int rr[2];
#pragma unroll
        for (int u = 0; u < 2; ++u) {
            const int idx = idx0 + u * stride; ok[u] = idx < nrows; const int ii = ok[u] ? idx : 0;
            const int rho = rowmode == 0 ? ii : (rowmode == 1 ? (ii >> 14) * MH + (ii & 16383) : (ii >> 10) * MH + 16384 + (ii & 1023)); rr[u] = rho; int b = 0, t = 0, ic = 0; row_info(rho, b, t, ic);
            const float* hp = first ? in_ptr(p, b, t, ic) : h_ptr(p, b, t, ic); hd[u] = h_ptr(p, b, t, ic);
            const float* m = mv + ((size_t)layer * 9 + (ic ? 8 : b)) * 9216 + j * 3072 + 2048; const bf16_t* o = outf + (size_t)rho * 1024;
            m2[u] = nl >= 0 ? mv + ((size_t)nl * 9 + (ic ? 8 : b)) * 9216 + nj * 3072 : mv;
            s[u] = 0.f; q[u] = 0.f;
            if (ok[u]) {
#pragma unroll
                for (int i = 0; i < 4; ++i) { const int d = i * 256 + lane * 4; const f32x4 h = __builtin_nontemporal_load((const f32x4*)(hp + d)), g = *(const f32x4*)(m + d); const u32x2 ow = __builtin_nontemporal_load((const u32x2*)(o + d)); const f32x4 ov = {lo2f(ow.x), hi2f(ow.x), lo2f(ow.y), hi2f(ow.y)};
                    if (nl >= 0) { shv[u][i] = *(const f32x4*)(m2[u] + d); scv[u][i] = *(const f32x4*)(m2[u] + 1024 + d); }
                    v[u][i] = ALPHA * h + wgt * g * ov; s[u] += v[u][i][0] + v[u][i][1] + v[u][i][2] + v[u][i][3];
                    q[u] += v[u][i][0] * v[u][i][0] + v[u][i][1] * v[u][i][1] + v[u][i][2] * v[u][i][2] + v[u][i][3] * v[u][i][3]; }
            } else {
#pragma unroll
                for (int i = 0; i < 4; ++i) v[u][i] = (f32x4){0.f, 0.f, 0.f, 0.f};
            }
        }
#pragma unroll
        for (int u = 0; u < 2; ++u) {
            const float mu = wave_sum(s[u]) * (1.f / 1024.f); const float var = fmaxf(wave_sum(q[u]) * (1.f / 1024.f) - mu * mu, 0.f); const float rs = rsqrtf(var + 1e-5f);
            if (ok[u]) {
#pragma unroll
                for (int i = 0; i < 4; ++i) { const int d = i * 256 + lane * 4; const f32x4 hn = (v[u][i] - mu) * rs * lgv[i] + lbv[i];
                    __builtin_nontemporal_store(hn, (f32x4*)(hd[u] + d));
                    if (nl >= 0) { const f32x4 sh = shv[u][i], sc = scv[u][i];
                        u32x2 w; w.x = cvt_pk_bf16(hn[0] * (1.f + sc[0]) + sh[0], hn[1] * (1.f + sc[1]) + sh[1]); w.y = cvt_pk_bf16(hn[2] * (1.f + sc[2]) + sh[2], hn[3] * (1.f + sc[3]) + sh[3]);
                        *(u32x2*)(abf + (size_t)rr[u] * 1024 + d) = w; } }
            }
        }
    }
}

DI int scan_row(int gs, int bl, int d) {
    if (gs < 256) return 16384 + bl * 256 + (d ? 255 - gs : gs);
    const int t = gs - 256; return bl * 4096 + (d ? 4095 - t : t);
}
DI void cvt8(const u32x4 w, float* o) { o[0] = lo2f(w.x); o[1] = hi2f(w.x); o[2] = lo2f(w.y); o[3] = hi2f(w.y); o[4] = lo2f(w.z); o[5] = hi2f(w.z); o[6] = lo2f(w.w); o[7] = hi2f(w.w); }

typedef float f32x2 __attribute__((ext_vector_type(2)));
#define ST8(dst, f) do { *(f32x4*)(dst) = (f32x4){f[0], f[1], f[2], f[3]}; *(f32x4*)((dst) + 4) = (f32x4){f[4], f[5], f[6], f[7]}; } while (0)
DI float dpp_sum8(float x) {
    x += __int_as_float(__builtin_amdgcn_update_dpp(0, __float_as_int(x), 0xB1, 0xF, 0xF, true));
    x += __int_as_float(__builtin_amdgcn_update_dpp(0, __float_as_int(x), 0x4E, 0xF, 0xF, true));
    x += __int_as_float(__builtin_amdgcn_update_dpp(0, __float_as_int(x), 0x141, 0xF, 0xF, true));
    return x;
}
#define P2(v, i) ((f32x2){(v)[i], (v)[(i) + 1]})
DI void phase_scan(int tidx, int bidx, Params& p, float* lds) {
    const int tid = tidx, wid = tid >> 6, lane = tid & 63; const int li = tid - 256, lstep = li >> 3, lgrp = li & 7;
    bf16_t* Ub = (bf16_t*)(p.ws + OFF_U);
    for (int unit = bidx; unit < 256; unit += gridDim.x) {
        __syncthreads();
        if (unit < 128) {
            constexpr int ST = 356, BUF = 32 * ST;
            const bf16_t* PR = (const bf16_t*)(p.ws + OFF_PR); const bf16_t* PK = (const bf16_t*)(p.ws + OFF_PK); const bf16_t* PV = (const bf16_t*)(p.ws + OFF_PV);
            const bf16_t* PKK = (const bf16_t*)(p.ws + OFF_PKK); const bf16_t* PBB = (const bf16_t*)(p.ws + OFF_PBB); const __half* PEW = (const __half*)(p.ws + OFF_PEW);
            const int rh = (unit >> 3) & 1, scan = (unit >> 4) * 8 + (unit & 7); const int d = scan & 1, h = (scan >> 1) & 7, bl = scan >> 4;
            bf16_t* Y = Ub + 1024 + d * 512 + h * 64 + rh * 32;
            const int ks = lane & 7, rowl = wid * 8 + (lane >> 3);
            f32x2 S0 = {0.f, 0.f}, S1 = {0.f, 0.f}, S2 = {0.f, 0.f}, S3 = {0.f, 0.f};
            u32x4 A0, A1, A2, A3, A4, A5; A0 = A1 = A2 = A3 = A4 = A5 = (u32x4){0u, 0u, 0u, 0u}; int Arow = 0;
            u32x4 B0, B1, B2, B3, B4, B5; B0 = B1 = B2 = B3 = B4 = B5 = (u32x4){0u, 0u, 0u, 0u}; int Brow = 0;
#define RW_LOAD(ch, G) do { G##row = scan_row((ch) * 32 + lstep, bl, d); const size_t o = (size_t)G##row * 512 + h * 64 + lgrp * 8; \
                G##0 = *(const u32x4*)(PR + o); G##1 = *(const u32x4*)(PK + o); G##2 = *(const u32x4*)(PKK + o); G##3 = *(const u32x4*)(PBB + o); \
                G##4 = *(const u32x4*)(PEW + ((size_t)G##row * 2 + d) * 512 + h * 64 + lgrp * 8); \
                if (lgrp < 4) G##5 = *(const u32x4*)(PV + (size_t)G##row * 512 + h * 64 + rh * 32 + lgrp * 8); } while (0)
#define RW_STORE(bi, C) do { float* dst = lds + (bi) * BUF + lstep * ST; float f[8]; \
                cvt8(C##0, f); ST8(dst + lgrp * 8, f); \
                { const __half2* e2 = (const __half2*)&C##4; _Pragma("unroll") for (int q = 0; q < 4; ++q) { const float2 ef = __half22float2(e2[q]); f[2 * q] = __expf(-ef.x); f[2 * q + 1] = __expf(-ef.y); } } \
                ST8(dst + 64 + lgrp * 8, f); cvt8(C##1, f); ST8(dst + 128 + lgrp * 8, f); \
                cvt8(C##2, f); _Pragma("unroll") for (int q = 0; q < 8; ++q) f[q] = -f[q]; ST8(dst + 192 + lgrp * 8, f); cvt8(C##3, f); ST8(dst + 256 + lgrp * 8, f); \
                if (lgrp < 4) { cvt8(C##5, f); ST8(dst + 320 + lgrp * 8, f); } if (lgrp == 0) ((int*)dst)[352] = C##row; } while (0)
            if (tid >= 256) {
                RW_LOAD(0, A); RW_LOAD(1, B); RW_STORE(0, A);
                lds_barrier();
                for (int ch = 0; ch < 136; ch += 2) {
                    { const int cn = ch + 2 < 136 ? ch + 2 : 135; RW_LOAD(cn, A); } RW_STORE(1, B); lds_barrier();
                    { const int cn = ch + 3 < 136 ? ch + 3 : 135; RW_LOAD(cn, B); } RW_STORE(0, A); lds_barrier();
                }
            } else {
                lds_barrier();
                for (int ch = 0; ch < 136; ++ch) {
                {
                    const float* buf = lds + (ch & 1) * BUF;
                    f32x4 nra = *(const f32x4*)(buf + ks * 8), nrb = *(const f32x4*)(buf + ks * 8 + 4), nwa = *(const f32x4*)(buf + 64 + ks * 8), nwb = *(const f32x4*)(buf + 64 + ks * 8 + 4);
                    f32x4 nka = *(const f32x4*)(buf + 128 + ks * 8), nkb = *(const f32x4*)(buf + 128 + ks * 8 + 4), nza = *(const f32x4*)(buf + 192 + ks * 8), nzb = *(const f32x4*)(buf + 192 + ks * 8 + 4);
                    f32x4 nba = *(const f32x4*)(buf + 256 + ks * 8), nbb = *(const f32x4*)(buf + 256 + ks * 8 + 4); float nv = buf[320 + rowl];
                    float sa; { f32x2 dz = S0 * P2(nza, 0); dz = S1 * P2(nza, 2) + dz; dz = S2 * P2(nzb, 0) + dz; dz = S3 * P2(nzb, 2) + dz; sa = dpp_sum8(dz[0] + dz[1]); }
                    for (int sh = 0; sh < 4; ++sh) {
                        float ykeep = 0.f;
#pragma unroll 2
                        for (int s = 0; s < 8; ++s) {
                            const f32x4 ra = nra, rb = nrb, wa = nwa, wb = nwb, ka = nka, kb = nkb, ba = nba, bb = nbb; const float vv = nv;
                            { const float* bq = buf + (sh * 8 + s + 1) * ST;
                              nra = *(const f32x4*)(bq + ks * 8); nrb = *(const f32x4*)(bq + ks * 8 + 4); nwa = *(const f32x4*)(bq + 64 + ks * 8); nwb = *(const f32x4*)(bq + 64 + ks * 8 + 4);
                              nka = *(const f32x4*)(bq + 128 + ks * 8); nkb = *(const f32x4*)(bq + 128 + ks * 8 + 4); nza = *(const f32x4*)(bq + 192 + ks * 8); nzb = *(const f32x4*)(bq + 192 + ks * 8 + 4);
                              nba = *(const f32x4*)(bq + 256 + ks * 8); nbb = *(const f32x4*)(bq + 256 + ks * 8 + 4); nv = bq[320 + rowl]; }
                            const f32x2 vv2 = {vv, vv}, sa2 = {sa, sa};
                            S0 = S0 * P2(wa, 0) + (sa2 * P2(ba, 0) + vv2 * P2(ka, 0)); S1 = S1 * P2(wa, 2) + (sa2 * P2(ba, 2) + vv2 * P2(ka, 2));
                            S2 = S2 * P2(wb, 0) + (sa2 * P2(bb, 0) + vv2 * P2(kb, 0)); S3 = S3 * P2(wb, 2) + (sa2 * P2(bb, 2) + vv2 * P2(kb, 2));
                            f32x2 dy = S0 * P2(ra, 0); dy = S1 * P2(ra, 2) + dy; dy = S2 * P2(rb, 0) + dy; dy = S3 * P2(rb, 2) + dy;
                            f32x2 dz = S0 * P2(nza, 0); dz = S1 * P2(nza, 2) + dz; dz = S2 * P2(nzb, 0) + dz; dz = S3 * P2(nzb, 2) + dz;
                            float yy = dy[0] + dy[1], zz = dz[0] + dz[1];
                            yy += __int_as_float(__builtin_amdgcn_update_dpp(0, __float_as_int(yy), 0xB1, 0xF, 0xF, true)); zz += __int_as_float(__builtin_amdgcn_update_dpp(0, __float_as_int(zz), 0xB1, 0xF, 0xF, true));
                            yy += __int_as_float(__builtin_amdgcn_update_dpp(0, __float_as_int(yy), 0x4E, 0xF, 0xF, true)); zz += __int_as_float(__builtin_amdgcn_update_dpp(0, __float_as_int(zz), 0x4E, 0xF, 0xF, true));
                            yy += __int_as_float(__builtin_amdgcn_update_dpp(0, __float_as_int(yy), 0x141, 0xF, 0xF, true)); zz += __int_as_float(__builtin_amdgcn_update_dpp(0, __float_as_int(zz), 0x141, 0xF, 0xF, true));
                            sa = zz;
                            ykeep = (s == ks) ? yy : ykeep;
                        }
                        const int row = ((const int*)(buf + (sh * 8 + ks) * ST))[352];
                        Y[(size_t)row * 4608 + rowl] = f2bf(ykeep);
                    }
                }
                lds_barrier();
                }
            }
        } else {
            constexpr int ST = 292, BUF = 32 * ST;
            const bf16_t* U = Ub + 2048; const float* lbv = (const float*)(p.ws + OFF_MISC);
            const int u2 = unit - 128; const int vq = (u2 >> 3) & 3, scan = (u2 >> 5) * 8 + (u2 & 7); const int d = scan & 1, h = (scan >> 1) & 3, bl = scan >> 3;
            bf16_t* O = Ub + d * 512 + h * 128 + vq * 32;
            const int ksl = lane & 7, vcol = wid * 8 + (lane >> 3);
            f32x2 S[8];
#pragma unroll
            for (int q = 0; q < 8; ++q) S[q] = (f32x2){0.f, 0.f};
            u32x4 A0, A1, A2, A3, A4; A0 = A1 = A2 = A3 = A4 = (u32x4){0u, 0u, 0u, 0u}; int Arow = 0;
            u32x4 B0, B1, B2, B3, B4; B0 = B1 = B2 = B3 = B4 = (u32x4){0u, 0u, 0u, 0u}; int Brow = 0;
#define HG_LOAD(ch, G) do { G##row = scan_row((ch) * 32 + lstep, bl, d); const bf16_t* ur = U + (size_t)G##row * 4608; \
                G##0 = *(const u32x4*)(ur + h * 128 + lgrp * 16); G##1 = *(const u32x4*)(ur + h * 128 + lgrp * 16 + 8); \
                G##2 = *(const u32x4*)(ur + 512 + d * 512 + h * 128 + lgrp * 16); G##3 = *(const u32x4*)(ur + 512 + d * 512 + h * 128 + lgrp * 16 + 8); \
                if (lgrp < 4) G##4 = *(const u32x4*)(ur + 1536 + h * 128 + vq * 32 + lgrp * 8); } while (0)
#define HG_STORE(bi, C) do { float* dst = lds + (bi) * BUF + lstep * ST; float f[8]; \
                cvt8(C##0, f); ST8(dst + lgrp * 16, f); \
                cvt8(C##1, f); ST8(dst + lgrp * 16 + 8, f); \
                cvt8(C##2, f); _Pragma("unroll") for (int q = 0; q < 8; ++q) f[q] = 1.f - f[q]; ST8(dst + 128 + lgrp * 16, f); \
                cvt8(C##3, f); _Pragma("unroll") for (int q = 0; q < 8; ++q) f[q] = 1.f - f[q]; ST8(dst + 128 + lgrp * 16 + 8, f); \
                if (lgrp < 4) { cvt8(C##4, f); ST8(dst + 256 + lgrp * 8, f); } if (lgrp == 0) ((int*)dst)[288] = C##row; } while (0)
            if (tid >= 256) {
                HG_LOAD(0, A); HG_LOAD(1, B); HG_STORE(0, A);
                lds_barrier();
                for (int ch = 0; ch < 136; ch += 2) {
                    { const int cn = ch + 2 < 136 ? ch + 2 : 135; HG_LOAD(cn, A); } HG_STORE(1, B); lds_barrier();
                    { const int cn = ch + 3 < 136 ? ch + 3 : 135; HG_LOAD(cn, B); } HG_STORE(0, A); lds_barrier();
                }
            } else {
                lds_barrier();
                for (int ch = 0; ch < 136; ++ch) {
                {
                    const float* buf = lds + (ch & 1) * BUF;
                    f32x4 nq[4], nf[4];
#pragma unroll
                    for (int q = 0; q < 4; ++q) { nq[q] = *(const f32x4*)(buf + ksl * 16 + q * 4); nf[q] = *(const f32x4*)(buf + 128 + ksl * 16 + q * 4); }
                    float niv = buf[256 + vcol];
                    for (int sh = 0; sh < 4; ++sh) {
                        float okeep = 0.f;
#pragma unroll 2
                        for (int s = 0; s < 8; ++s) {
                            f32x4 cq[4], cf[4];
#pragma unroll
                            for (int q = 0; q < 4; ++q) { cq[q] = nq[q]; cf[q] = nf[q]; }
                            const float iv = niv;
                            { const float* bq = buf + (sh * 8 + s + 1) * ST;
#pragma unroll
                              for (int q = 0; q < 4; ++q) { nq[q] = *(const f32x4*)(bq + ksl * 16 + q * 4); nf[q] = *(const f32x4*)(bq + 128 + ksl * 16 + q * 4); }
                              niv = bq[256 + vcol]; }
                            const f32x2 iv2 = {iv, iv}; f32x2 o2 = {0.f, 0.f};
#pragma unroll
                            for (int q = 0; q < 4; ++q) {
                                const f32x2 fa = P2(cf[q], 0), fb = P2(cf[q], 2);
                                S[2 * q] = fa * S[2 * q] + (iv2 - fa * iv2); S[2 * q + 1] = fb * S[2 * q + 1] + (iv2 - fb * iv2);
                                o2 = S[2 * q] * P2(cq[q], 0) + o2; o2 = S[2 * q + 1] * P2(cq[q], 2) + o2;
                            }
                            const float o = dpp_sum8(o2[0] + o2[1]);
                            okeep = (s == ksl) ? o : okeep;
                        }
                        const int row = ((const int*)(buf + (sh * 8 + ksl) * ST))[288];
                        O[(size_t)row * 4608 + vcol] = f2bf(okeep);
                    }
                }
                lds_barrier();
                }
            }
        }
    }
}

DI void ld8bf(const bf16_t* p, float* o) { const u32x4 w = *(const u32x4*)p; cvt8(w, o); }
DI void ld8bf_nt(const bf16_t* p, float* o) { const u32x4 w = __builtin_nontemporal_load((const u32x4*)p); cvt8(w, o); }
DI void ld8f(const float* p, float* o) { const f32x4 a = *(const f32x4*)p, b = *(const f32x4*)(p + 4); o[0] = a[0]; o[1] = a[1]; o[2] = a[2]; o[3] = a[3]; o[4] = b[0]; o[5] = b[1]; o[6] = b[2]; o[7] = b[3]; }
DI u32x4 pack8(const float* f) { u32x4 w; w.x = cvt_pk_bf16(f[0], f[1]); w.y = cvt_pk_bf16(f[2], f[3]); w.z = cvt_pk_bf16(f[4], f[5]); w.w = cvt_pk_bf16(f[6], f[7]); return w; }
DI void shifted8(const bf16_t* U, size_t r, int col, int t, int T, const float* mu, float* o) {
    float c[8], a[8], b[8]; ld8bf(U + r * 4608 + col, c);
    if (t > 0) ld8bf(U + (r - 1) * 4608 + col, a); else {
#pragma unroll
        for (int q = 0; q < 8; ++q) a[q] = 0.f; }
    if (t < T - 1) ld8bf(U + (r + 1) * 4608 + col, b); else {
#pragma unroll
        for (int q = 0; q < 8; ++q) b[q] = 0.f; }
#pragma unroll
    for (int q = 0; q < 8; ++q) o[q] = c[q] + mu[q] * (0.5f * (a[q] + b[q]) - c[q]);
}
#define MFMA32(a, b, c) __builtin_amdgcn_mfma_f32_32x32x16_bf16((a), (b), (c), 0, 0, 0)
#define LORA_MFMA(WT, KT, KB, NS) do { _Pragma("unroll") for (int n = 0; n < 2; ++n) _Pragma("unroll") for (int r = 0; r < 16; ++r) acc[n][r] = 0.f; \
    for (int st = 0; st < (NS); ++st) { const bf16x8 af = *(const bf16x8*)(inl + l31 * 360 + (KB) + st * 16 + hf * 8); \
        _Pragma("unroll") for (int n = 0; n < 2; ++n) { const bf16x8 bfr = *(const bf16x8*)((WT) + (size_t)(wid * 64 + n * 32 + l31) * (KT) + st * 16 + hf * 8); acc[n] = MFMA32(af, bfr, acc[n]); } } } while (0)

DI void phase_rwprep(int tidx, int bidx, Params& p, char* ldsb) {
    const int tid = tidx, wid = tid >> 6, lane = tid & 63, l31 = lane & 31, hf = lane >> 5; const bf16_t* U = (const bf16_t*)(p.ws + OFF_U);
    bf16_t* PR = (bf16_t*)(p.ws + OFF_PR); bf16_t* PK = (bf16_t*)(p.ws + OFF_PK); bf16_t* PV = (bf16_t*)(p.ws + OFF_PV); bf16_t* PKK = (bf16_t*)(p.ws + OFF_PKK); bf16_t* PBB = (bf16_t*)(p.ws + OFF_PBB);
    __half* PEW = (__half*)(p.ws + OFF_PEW); bf16_t* PG = (bf16_t*)(p.ws + OFF_PG);
    const bf16_t* LW = (const bf16_t*)(p.ws + OFF_LW); const bf16_t* a2T = LW; const bf16_t* w2T = LW + 32768; const bf16_t* g2T = LW + 98304;
    bf16_t* inl = (bf16_t*)ldsb; float* al = (float*)(ldsb + 23040);
    const int c0 = (tid & 63) * 8;
    float mur[8], muk[8], muv[8], kkc[8], kac[8];
    ld8f(p.rw_mu + c0, mur); ld8f(p.rw_mu + 512 + c0, muk); ld8f(p.rw_mu + 1024 + c0, muv); ld8f(p.rw_k_k + c0, kkc); ld8f(p.rw_k_a + c0, kac);
    for (int tile = bidx; tile < 544; tile += gridDim.x) {
        int row0, t0, T;
        if (tile < 512) { row0 = tile * 32; t0 = row0 & 4095; T = 4096; } else { row0 = 16384 + (tile - 512) * 32; t0 = ((tile - 512) * 32) & 255; T = 256; }
        __syncthreads();
        for (int i = tid; i < 32 * 44; i += 512) { const int tok = i / 44, g = i - tok * 44; float mu[8], x[8]; ld8f(p.rw_mu + 1536 + g * 8, mu);
            shifted8(U, (size_t)(row0 + tok), 1536 + g * 8, t0 + tok, T, mu, x);
#pragma unroll
            for (int q = 0; q < 8; ++q) x[q] = g < 16 ? tanhf(x[q]) : (g < 24 ? x[q] : sigmoidf_(x[q]));
            *(u32x4*)(inl + tok * 360 + g * 8) = pack8(x); }
        __syncthreads();
        f32x16 acc[2];
        LORA_MFMA(a2T, 64, 128, 4);
#pragma unroll
        for (int n = 0; n < 2; ++n) { const int c = wid * 64 + n * 32 + l31; const float a0c = p.rw_a0[c];
#pragma unroll
            for (int r = 0; r < 16; ++r) al[(8 * (r >> 2) + 4 * hf + (r & 3)) * 516 + c] = sigmoidf_(a0c + acc[n][r]); }
        LORA_MFMA(w2T, 64, 0, 4);
#pragma unroll
        for (int n = 0; n < 2; ++n) { const int c = wid * 64 + n * 32 + l31; const float w0c = p.rw_w0[c];
#pragma unroll
            for (int r = 0; r < 16; ++r) PEW[((size_t)(row0 + 8 * (r >> 2) + 4 * hf + (r & 3)) * 2 + 0) * 512 + c] = __float2half(0.6065306597126334f * sigmoidf_(w0c + acc[n][r])); }
        LORA_MFMA(w2T + 32768, 64, 64, 4);
#pragma unroll
        for (int n = 0; n < 2; ++n) { const int c = wid * 64 + n * 32 + l31; const float w0c = p.rw_w0[512 + c];
#pragma unroll
            for (int r = 0; r < 16; ++r) PEW[((size_t)(row0 + 8 * (r >> 2) + 4 * hf + (r & 3)) * 2 + 1) * 512 + c] = __float2half(0.6065306597126334f * sigmoidf_(w0c + acc[n][r])); }
        LORA_MFMA(g2T, 160, 192, 10);
#pragma unroll
        for (int n = 0; n < 2; ++n) { const int c = wid * 64 + n * 32 + l31;
#pragma unroll
            for (int r = 0; r < 16; ++r) PG[(size_t)(row0 + 8 * (r >> 2) + 4 * hf + (r & 3)) * 512 + c] = f2bf(acc[n][r]); }
        __syncthreads();
#pragma unroll 1
        for (int q4 = 0; q4 < 4; ++q4) { const int tok = (tid >> 6) + 8 * q4; const size_t r = (size_t)(row0 + tok); const int t = t0 + tok;
            float rr[8], kr[8], vr[8], a[8], o1[8], o2[8];
            shifted8(U, r, c0, t, T, mur, rr); shifted8(U, r, 512 + c0, t, T, muk, kr); shifted8(U, r, 1024 + c0, t, T, muv, vr); ld8f(al + tok * 516 + c0, a);
            float ss = 0.f;
#pragma unroll
            for (int q = 0; q < 8; ++q) { o1[q] = kr[q] * kkc[q]; ss += o1[q] * o1[q]; }
            ss = dpp_sum8(ss); const float inv = 1.f / fmaxf(sqrtf(ss), 1e-12f);
#pragma unroll
            for (int q = 0; q < 8; ++q) { o1[q] *= inv; o2[q] = o1[q] * a[q]; kr[q] = kr[q] * (1.f + (a[q] - 1.f) * kac[q]); }
            *(u32x4*)(PR + r * 512 + c0) = pack8(rr); *(u32x4*)(PK + r * 512 + c0) = pack8(kr); *(u32x4*)(PV + r * 512 + c0) = pack8(vr);
            *(u32x4*)(PKK + r * 512 + c0) = pack8(o1); *(u32x4*)(PBB + r * 512 + c0) = pack8(o2); }
    }
}

DI void phase_read(int tidx, int bidx, Params& p, int half) {
    const int wid = tidx >> 6, lane = tidx & 63;
    const bf16_t* Ub = (const bf16_t*)(p.ws + OFF_U); bf16_t* mix = (bf16_t*)(p.ws + OFF_ABF) + (size_t)half * MH * 1024;
    const bf16_t* PR = (const bf16_t*)(p.ws + OFF_PR); const bf16_t* PK = (const bf16_t*)(p.ws + OFF_PK); const bf16_t* PV = (const bf16_t*)(p.ws + OFF_PV); const bf16_t* PG = (const bf16_t*)(p.ws + OFF_PG);
    const int c0 = lane * 8;
    float gg[8], gb[8], rk[8], hn[8]; ld8f(p.rw_gn_g + c0, gg); ld8f(p.rw_gn_b + c0, gb); ld8f(p.rw_r_k + c0, rk); ld8f(p.hg_norm_g + (c0 & 127), hn);
    for (int r = bidx * 8 + wid; r < MH; r += gridDim.x * 8) {
        const bf16_t* ur = Ub + (size_t)r * 4608; const size_t o = (size_t)r * 512 + c0;
        float y0[8], y1[8], rr[8], kk[8], vv[8], g[8], o0[8], o1[8], hg[8];
        ld8bf_nt(ur + 1024 + c0, y0); ld8bf_nt(ur + 1536 + c0, y1); ld8bf_nt(PR + o, rr); ld8bf_nt(PK + o, kk); ld8bf_nt(PV + o, vv); ld8bf_nt(PG + o, g);
        ld8bf_nt(ur + c0, o0); ld8bf_nt(ur + 512 + c0, o1); ld8bf_nt(ur + 4096 + c0, hg);
        float s = 0.f, q = 0.f, d = 0.f;
#pragma unroll
        for (int k = 0; k < 8; ++k) { y0[k] += y1[k]; s += y0[k]; q += y0[k] * y0[k]; d += rr[k] * kk[k] * rk[k]; }
        s = dpp_sum8(s); q = dpp_sum8(q); d = dpp_sum8(d);
        const float mu = s * (1.f / 64.f); const float rs = rsqrtf(fmaxf(q * (1.f / 64.f) - mu * mu, 0.f) + 64e-5f);
#pragma unroll
        for (int k = 0; k < 8; ++k) y0[k] = ((y0[k] - mu) * rs * gg[k] + gb[k] + d * vv[k]) * g[k];
        *(u32x4*)(mix + (size_t)r * 1024 + c0) = pack8(y0);
        float ss = 0.f;
#pragma unroll
        for (int k = 0; k < 8; ++k) { o0[k] += o1[k]; ss += o0[k] * o0[k]; }
        ss = dpp_sum16(ss); const float rh = rsqrtf(ss * (1.f / 128.f) + 1e-5f);
#pragma unroll
        for (int k = 0; k < 8; ++k) o0[k] = o0[k] * rh * hn[k] * hg[k];
        *(u32x4*)(mix + (size_t)r * 1024 + 512 + c0) = pack8(o0);
    }
}

DI int attn_row(int b, int s) {
    const int hb = b >> 2, bl = b & 3; return s < 256 ? hb * MH + 16384 + bl * 256 + s : hb * MH + bl * 4096 + (s - 256);
}
DI void phase_attnprep(int tidx, int bidx, Params& p, bf16_t* lds) {
    const int tid = tidx, wid = tid >> 6, lane = tid & 63; bf16_t* U = (bf16_t*)(p.ws + OFF_U3); const float* rope = (const float*)(p.ws + OFF_ROPE);
    bf16_t* VT = (bf16_t*)(p.ws + OFF_VT);
    for (int unit = bidx; unit < 8 * 68 * 8; unit += gridDim.x) {
        const int h = unit & 7, st = (unit >> 3) % 68, b = unit / (68 * 8); const int s0 = st * 64; const int row0 = attn_row(b, s0);
        __syncthreads();
#pragma unroll
        for (int q = 0; q < 2; ++q) { const int i = tid + q * 512, tok = i >> 4, seg = i & 15;
            const u32x4 v = *(const u32x4*)(U + (size_t)(row0 + tok) * 3072 + 2048 + h * 128 + seg * 8);
            unsigned* d = (unsigned*)(lds + tok * 136 + seg * 8); d[0] = v.x; d[1] = v.y; d[2] = v.z; d[3] = v.w; }
        __syncthreads();
#pragma unroll
        for (int q = 0; q < 2; ++q) { const int i = tid + q * 512, e = i >> 3, seg = i & 7; const bf16_t* l = lds + ((seg >> 1) * 16 + (seg & 1) * 4) * 136 + e;
            u32x4 w; w.x = (unsigned)l[0] | ((unsigned)l[136] << 16); w.y = (unsigned)l[272] | ((unsigned)l[408] << 16); w.z = (unsigned)l[8 * 136] | ((unsigned)l[9 * 136] << 16); w.w = (unsigned)l[10 * 136] | ((unsigned)l[11 * 136] << 16);
            *(u32x4*)(VT + ((size_t)(b * 8 + h) * 128 + e) * 4352 + s0 + seg * 8) = w; }
    }
    __syncthreads();
    for (int lr = bidx * 8 + wid; lr < NLAT; lr += gridDim.x * 8) {
        const int b = lr >> 12, t = lr & 4095; bf16_t* ur = U + (size_t)attn_row(b, 256 + t) * 3072; const float* rp = rope + t * 64;
#pragma unroll
        for (int q = 0; q < 2; ++q) { const int it = q * 64 + lane; const int vec = it >> 2, bp = it & 3; const int blk = (bp & 1) + (bp >> 1) * 4;
            bf16_t* pl = ur + vec * 64 + blk * 8; const float* cp = rp + (blk >> 2) * 16 + (blk & 1) * 8;
            float xl[8], xh[8], cs[8], sn[8], ol[8], oh[8]; ld8bf(pl, xl); ld8bf(pl + 16, xh); ld8f(cp, cs); ld8f(cp + 32, sn);
            const float sc = vec < 16 ? QSCALE : 1.f;
#pragma unroll
            for (int k = 0; k < 8; ++k) { ol[k] = (xl[k] * cs[k] - xh[k] * sn[k]) * sc; oh[k] = (xh[k] * cs[k] + xl[k] * sn[k]) * sc; }
            *(u32x4*)pl = pack8(ol); *(u32x4*)(pl + 16) = pack8(oh); }
    }
}

DI void attn_tile(const char* kb, const char* vb, const bf16x8 (&qf)[4], f32x16 (&o)[4], float& mrun, float& lsum, const bool first, const int l31, const int hf) {
    bf16x8 ka[2][4], av[2];
#pragma unroll
    for (int k2 = 0; k2 < 2; ++k2)
#pragma unroll
        for (int dc = 0; dc < 4; ++dc) ka[k2][dc] = *(const bf16x8*)(kb + (k2 * 32 + l31) * 144 + dc * 32 + hf * 16);
    f32x16 s[2];
    __builtin_amdgcn_s_setprio(1);
#pragma unroll
    for (int k2 = 0; k2 < 2; ++k2) {
#pragma unroll
        for (int r = 0; r < 16; ++r) s[k2][r] = -mrun;
#pragma unroll
        for (int dc = 0; dc < 4; ++dc) s[k2] = MFMA32(ka[k2][dc], qf[dc], s[k2]);
    }
    __builtin_amdgcn_s_setprio(0);
#pragma unroll
    for (int v = 0; v < 2; ++v) av[v] = *(const bf16x8*)(vb + (v * 32 + l31) * 144 + hf * 16);
    float mx = s[0][0];
#pragma unroll
    for (int k2 = 0; k2 < 2; ++k2)
#pragma unroll
        for (int r = 0; r < 16; ++r) mx = fmaxf(mx, s[k2][r]);
    mx = fmaxf(mx, __shfl_xor(mx, 32, 64));
    if (first || __any(mx > 8.f)) {
        const float dm = first ? mx : fmaxf(mx, 0.f); const float fs = first ? 1.f : __builtin_amdgcn_exp2f(-dm); mrun += dm; lsum *= fs;
#pragma unroll
        for (int v = 0; v < 4; ++v)
#pragma unroll
            for (int r = 0; r < 16; ++r) o[v][r] *= fs;
#pragma unroll
        for (int k2 = 0; k2 < 2; ++k2)
#pragma unroll
            for (int r = 0; r < 16; ++r) s[k2][r] -= dm;
    }
    float ps = 0.f;
#pragma unroll
    for (int k2 = 0; k2 < 2; ++k2)
#pragma unroll
        for (int r = 0; r < 16; ++r) { const float e = __builtin_amdgcn_exp2f(s[k2][r]); s[k2][r] = e; ps += e; }
    lsum += ps;
    bf16x8 pf;
    __builtin_amdgcn_s_setprio(1);
#pragma unroll
    for (int hs = 0; hs < 8; ++hs) {
        const int idx = hs >> 1, vh = hs & 1, k2 = idx >> 1, st = idx & 1;
        bf16x8 an[2];
        if (hs < 7) { const int ni = (hs + 1) >> 1, nvh = (hs + 1) & 1;
#pragma unroll
            for (int v = 0; v < 2; ++v) an[v] = *(const bf16x8*)(vb + ((nvh * 2 + v) * 32 + l31) * 144 + (ni * 16 + hf * 8) * 2); }
        if (vh == 0) { u32x4 pw; pw.x = cvt_pk_bf16(s[k2][8 * st], s[k2][8 * st + 1]); pw.y = cvt_pk_bf16(s[k2][8 * st + 2], s[k2][8 * st + 3]);
            pw.z = cvt_pk_bf16(s[k2][8 * st + 4], s[k2][8 * st + 5]); pw.w = cvt_pk_bf16(s[k2][8 * st + 6], s[k2][8 * st + 7]); pf = __builtin_bit_cast(bf16x8, pw); }
#pragma unroll
        for (int v = 0; v < 2; ++v) o[vh * 2 + v] = MFMA32(av[v], pf, o[vh * 2 + v]);
        if (hs < 7) { av[0] = an[0]; av[1] = an[1]; }
    }
    __builtin_amdgcn_s_setprio(0);
}

DI void phase_attn(int tidx, int bidx, Params& p, char* ldsb) {
    const int tid = tidx, wid = tid >> 6, lane = tid & 63, l31 = lane & 31, hf = lane >> 5; const int m = wid & 1, qsub = wid >> 1;
    const bf16_t* U = (const bf16_t*)(p.ws + OFF_U3); const bf16_t* VT = (const bf16_t*)(p.ws + OFF_VT); bf16_t* mix = (bf16_t*)(p.ws + OFF_ABF);
    const float lam = ((const float*)(p.ws + OFF_MISC))[512];
    constexpr int KB = 2 * 64 * 144, VB = 128 * 144, TB = KB + VB;
    for (int item = bidx; item < 2048; item += gridDim.x) {
        const int qb = (item >> 3) & 31, h = item & 7, b = item >> 8;
        const int qrow = attn_row(b, 256 + qb * 128 + qsub * 32 + l31);
        bf16x8 qf[4];
#pragma unroll
        for (int dc = 0; dc < 4; ++dc) qf[dc] = *(const bf16x8*)(U + (size_t)qrow * 3072 + h * 128 + m * 64 + dc * 16 + hf * 8);
        f32x16 o[4];
#pragma unroll
        for (int v = 0; v < 4; ++v)
#pragma unroll
            for (int r = 0; r < 16; ++r) o[v][r] = 0.f;
        float mrun = 0.f, lsum = 0.f;
        u32x4 kA0, kA1, vA0, vA1;
        const bf16_t* vtb = VT + (size_t)(b * 8 + h) * 128 * 4352;
#define ATT_LOAD(j, S) do { { const int i = tid; k##S##0 = *(const u32x4*)(U + (size_t)attn_row(b, (j) * 64 + (i >> 4)) * 3072 + 1024 + h * 128 + (i & 15) * 8); v##S##0 = *(const u32x4*)(vtb + (size_t)(i >> 3) * 4352 + (j) * 64 + (i & 7) * 8); } \
            { const int i = tid + 512; k##S##1 = *(const u32x4*)(U + (size_t)attn_row(b, (j) * 64 + (i >> 4)) * 3072 + 1024 + h * 128 + (i & 15) * 8); v##S##1 = *(const u32x4*)(vtb + (size_t)(i >> 3) * 4352 + (j) * 64 + (i & 7) * 8); } } while (0)
#define ATT_STORE(bufi, S) do { char* base = ldsb + (bufi) * TB; { const int i = tid; const int seg = i & 15; *(u32x4*)(base + ((seg >> 3) * 64 + (i >> 4)) * 144 + (seg & 7) * 16) = k##S##0; *(u32x4*)(base + KB + (i >> 3) * 144 + (i & 7) * 16) = v##S##0; } \
            { const int i = tid + 512; const int seg = i & 15; *(u32x4*)(base + ((seg >> 3) * 64 + (i >> 4)) * 144 + (seg & 7) * 16) = k##S##1; *(u32x4*)(base + KB + (i >> 3) * 144 + (i & 7) * 16) = v##S##1; } } while (0)
        __syncthreads();
        ATT_LOAD(0, A); ATT_STORE(0, A);
        __syncthreads();
        for (int j = 0; j < 68; ++j) {
            { const int jn = j + 1 < 68 ? j + 1 : 67; ATT_LOAD(jn, A); }
            attn_tile(ldsb + (j & 1) * TB + m * (64 * 144), ldsb + (j & 1) * TB + KB, qf, o, mrun, lsum, j == 0, l31, hf);
            ATT_STORE((j + 1) & 1, A);
            lds_barrier();
        }
        const float linv = 1.f / (lsum + __shfl_xor(lsum, 32, 64));
        float* ex = (float*)ldsb + (size_t)qsub * 4096;
        if (m == 1) {
#pragma unroll
            for (int v = 0; v < 4; ++v)
#pragma unroll
                for (int r = 0; r < 16; ++r) ex[(v * 16 + r) * 64 + lane] = o[v][r] * linv;
        }
        __syncthreads();
        if (m == 0) {
            float ss = 0.f;
#pragma unroll
            for (int v = 0; v < 4; ++v)
#pragma unroll
                for (int r = 0; r < 16; ++r) { const float x = o[v][r] * linv - lam * ex[(v * 16 + r) * 64 + lane]; o[v][r] = x; ss += x * x; }
            ss += __shfl_xor(ss, 32, 64); const float rs = rsqrtf(ss * (1.f / 128.f) + 1e-5f) * (1.f - LAM_INIT);
            bf16_t* orow = mix + (size_t)qrow * 1024 + h * 128;
#pragma unroll
            for (int v = 0; v < 4; ++v)
#pragma unroll
                for (int g = 0; g < 4; ++g) { const int e = v * 32 + 8 * g + 4 * hf; const f32x4 ng = *(const f32x4*)(p.da_norm_g + e);
                    u32x2 w; w.x = cvt_pk_bf16(o[v][4 * g] * rs * ng[0], o[v][4 * g + 1] * rs * ng[1]); w.y = cvt_pk_bf16(o[v][4 * g + 2] * rs * ng[2], o[v][4 * g + 3] * rs * ng[3]);
                    *(u32x2*)(orow + e) = w; }
        }
    }
}

enum { K_PRE = 0, K_MODFIN, K_MODIN, K_SWIGLU, K_F32, K_BF16, K_POSTNORM, K_RWPREP, K_SCAN, K_READ, K_MIX, K_ATTN };
constexpr int NPHASE = 33;
#ifndef ENMASK
#define ENMASK 0xFFFF
#endif
#define EN(k) ((ENMASK >> (k)) & 1)
#ifndef REPMASK
#define REPMASK 0
#endif

__global__ __launch_bounds__(512, 2) void mega(ParamsS pv, int ph0, int ph1) {
    extern __shared__ __attribute__((aligned(16))) unsigned char shm[];
    cg::grid_group grid = cg::this_grid();
    __shared__ uint4 xb_words;
    if (threadIdx.x == 0) xb_words = make_uint4(0u, 0u, 0u, 0u);
    __syncthreads();
    XcdBarrier xb = xcd_barrier_post((unsigned*)(pv.ws + OFF_BAR), (volatile LAS unsigned*)&xb_words);
    for (int ph = ph0; ph < ph1; ++ph) {
        int kind = 0, layer = 0, j = 0, first = 0, nl = -1, nj = 0, skip = 0, half = 0, widx = 0; float wgt = 0.5f;
        switch (ph) {
            case 0: kind = K_PRE; break;
            case 1: kind = K_MODFIN; break;
            case 2: kind = K_MODIN; break;
            case 3: kind = K_SWIGLU; widx = 0; break;
            case 4: kind = K_F32; widx = 0; skip = 1; break;
            case 5: kind = K_MIX; widx = 0; layer = 0; j = 0; first = 1; nl = 0; nj = 1; break;
            case 6: kind = K_POSTNORM; layer = 0; j = 0; first = 1; nl = 0; nj = 1; skip = 2; break;
            case 7: kind = K_BF16; widx = 0; half = 0; break;
            case 8: kind = K_RWPREP; break;
            case 9: kind = K_SCAN; break;
            case 10: kind = K_READ; half = 0; break;
            case 11: kind = K_BF16; widx = 0; half = 1; break;
            case 12: kind = K_RWPREP; break;
            case 13: kind = K_SCAN; break;
            case 14: kind = K_READ; half = 1; break;
            case 15: kind = K_F32; widx = 4; skip = 1; break;
            case 16: kind = K_MIX; widx = 4; layer = 0; j = 1; wgt = 1.f; nl = 0; nj = 2; break;
            case 17: kind = K_POSTNORM; layer = 0; j = 1; wgt = 1.f; nl = 0; nj = 2; skip = 2; break;
            case 18: kind = K_SWIGLU; widx = 1; break;
            case 19: kind = K_F32; widx = 1; skip = 1; break;
            case 20: kind = K_MIX; widx = 1; layer = 0; j = 2; nl = 1; nj = 0; break;
            case 21: kind = K_POSTNORM; layer = 0; j = 2; nl = 1; nj = 0; skip = 2; break;
            case 22: kind = K_SWIGLU; widx = 2; break;
            case 23: kind = K_F32; widx = 2; skip = 1; break;
            case 24: kind = K_MIX; widx = 2; layer = 1; j = 0; nl = 1; nj = 1; break;
            case 25: kind = K_POSTNORM; layer = 1; j = 0; nl = 1; nj = 1; skip = 2; break;
            case 26: kind = K_BF16; widx = 1; break;
            case 27: kind = K_ATTN; break;
            case 28: kind = K_F32; widx = 5; skip = 1; break;
            case 29: kind = K_POSTNORM; layer = 1; j = 1; wgt = 1.f; nl = 1; nj = 2; skip = 1; break;
            case 30: kind = K_SWIGLU; widx = 3; skip = 1; break;
            case 31: kind = K_F32; widx = 3; skip = 1; break;
            default: kind = K_POSTNORM; layer = 1; j = 2; nl = -1; skip = 1; break;
        }
        for (int rep = 0; rep < 1 + ((REPMASK >> kind) & 1); ++rep) {
        if (rep) __syncthreads();
        const __attribute__((address_space(4))) char* ka = (const __attribute__((address_space(4))) char*)__builtin_amdgcn_kernarg_segment_ptr();
        asm volatile("" : "+s"(ka));
        Params& p = *(Params*)ka;
        int tidx = threadIdx.x; asm volatile("" : "+v"(tidx)); int bidx = blockIdx.x; asm volatile("" : "+s"(bidx));
        if (EN(K_SWIGLU) && kind == K_SWIGLU) {
            Gemm g; g.A = (const bf16_t*)(p.ws + OFF_ABF); g.Bt = (const bf16_t*)(p.ws + OFF_WFI + widx * SZ_WFI); g.M = skip ? NLAT : MROWS; g.N = 5632; g.K = 1024;
            Order S; S.init(g.M, g.N, (int)gridDim.x, bidx, skip); EpiSwiglu E; E.O = (bf16_t*)(p.ws + OFF_HID); E.ldc = FF;
            pg8::gemm_phase<EpiSwiglu, Order, false>(tidx, (PG8_LAS unsigned char*)shm, g, S, E, nullptr);
        } else if (EN(K_F32) && (kind == K_F32 || (kind == K_MIX && bidx < 32))) {
            const int mode = kind == K_MIX ? 2 : skip; const int G = kind == K_MIX ? 32 : (int)gridDim.x;
            Gemm g; g.M = mode == 2 ? 2048 : (mode == 1 ? NLAT : MROWS); g.N = 1024;
            if (widx < 4) { g.A = (const bf16_t*)(p.ws + OFF_HID); g.Bt = (const bf16_t*)(p.ws + OFF_WFO + widx * SZ_WFO); g.K = FF; }
            else { g.A = (const bf16_t*)(p.ws + OFF_ABF); g.Bt = (const bf16_t*)(p.ws + (widx == 4 ? OFF_WEO : OFF_WOO)); g.K = 1024; }
            Order S; S.init(g.M, g.N, G, bidx, mode); pg8::EpiBf16<0> E; E.O = (bf16_t*)(p.ws + OFF_OUTF); E.ldc = 1024; E.bias = nullptr; E.split_cols = 0; E.split_stride = 0;
            pg8::gemm_phase<pg8::EpiBf16<0>, Order, false>(tidx, (PG8_LAS unsigned char*)shm, g, S, E, nullptr);
        } else if (EN(K_BF16) && kind == K_BF16) {
            Gemm g; g.K = 1024;
            if (widx == 0) { g.A = (const bf16_t*)(p.ws + OFF_ABF) + (size_t)half * MH * 1024; g.Bt = (const bf16_t*)(p.ws + OFF_WEI); g.M = MH; g.N = 4608;
                EpiEven E; E.O = (bf16_t*)(p.ws + OFF_U); E.ldc = 4608; E.lb = (const float*)(p.ws + OFF_MISC);
                Order S; S.init(g.M, g.N, (int)gridDim.x, bidx, 0);
                pg8::gemm_phase<EpiEven, Order, false>(tidx, (PG8_LAS unsigned char*)shm, g, S, E, nullptr); }
            else { EpiOdd E; E.O = (bf16_t*)(p.ws + OFF_U3); E.VT = (bf16_t*)(p.ws + OFF_VT); E.rope = (const float*)(p.ws + OFF_ROPE);
                g.A = (const bf16_t*)(p.ws + OFF_ABF); g.Bt = (const bf16_t*)(p.ws + OFF_WOI); g.M = MROWS; g.N = 3072;
                Order S; S.init(g.M, g.N, (int)gridDim.x, bidx, 0);
                pg8::gemm_phase<EpiOdd, Order, false>(tidx, (PG8_LAS unsigned char*)shm, g, S, E, nullptr); }
        }
        else if (EN(K_PRE) && kind == K_PRE) phase_pre(tidx, bidx, p, (float*)shm);
        else if (EN(K_MODFIN) && kind == K_MODFIN) phase_modfin(tidx, bidx, p);
        else if (EN(K_MODIN) && kind == K_MODIN) phase_modin(tidx, bidx, p);
        else if (EN(K_POSTNORM) && kind == K_POSTNORM) phase_postnorm(tidx, bidx, p, layer, j, wgt, first, nl, nj, skip, 0, (int)gridDim.x);
        else if (EN(K_MIX) && kind == K_MIX) phase_postnorm(tidx, bidx, p, layer, j, wgt, first, nl, nj, 1, 32, (int)gridDim.x - 32);
        else if (EN(K_RWPREP) && kind == K_RWPREP) phase_rwprep(tidx, bidx, p, (char*)shm);
        else if (EN(K_SCAN) && kind == K_SCAN) phase_scan(tidx, bidx, p, (float*)shm);
        else if (EN(K_READ) && kind == K_READ) phase_read(tidx, bidx, p, half);
        else if (EN(K_ATTN)) phase_attn(tidx, bidx, p, (char*)shm);
        }
        if (ph + 1 < ph1) { if (ph1 < 0) grid.sync();
            xcd_barrier(xb); }
    }
}

extern "C" void kernel_launch(void* const* d_in, const int* in_sizes, int n_in, void* d_out, int out_size, void* d_ws, size_t ws_size, hipStream_t stream) {
    static int grid_blocks = 0;
    if (!grid_blocks) {
        hipFuncSetAttribute((const void*)mega, hipFuncAttributeMaxDynamicSharedMemorySize, LDS_BYTES);
        int dev = 0, cus = 0, per_cu = 0; hipGetDevice(&dev); hipDeviceGetAttribute(&cus, hipDeviceAttributeMultiprocessorCount, dev);
        hipOccupancyMaxActiveBlocksPerMultiprocessor(&per_cu, mega, 512, LDS_BYTES);
        if (per_cu < 1) per_cu = 1;
        grid_blocks = cus * 1;
        if (ws_size < WS_NEED) fprintf(stderr, "workspace too small: %zu < %zu\n", ws_size, (size_t)WS_NEED);
    }
    ParamsS p{};
    const float** f = (const float**)&p;
    for (int i = 0; i < 29; ++i) f[i] = (const float*)d_in[i];
    p.out = (float*)d_out; p.ws = (char*)d_ws;
    hipMemsetAsync((char*)d_ws + OFF_BAR, 0, 16384, stream);
#if COOP
    int ph0 = 0, ph1 = NPHASE; void* args[] = {&p, &ph0, &ph1};
    hipError_t e = hipLaunchCooperativeKernel((const void*)mega, dim3(grid_blocks), dim3(512), args, LDS_BYTES, stream);
    if (e != hipSuccess) fprintf(stderr, "cooperative launch failed: %s (grid %d)\n", hipGetErrorString(e), grid_blocks);
#else
    for (int ph = 0; ph < NPHASE; ++ph) mega<<<grid_blocks, 512, LDS_BYTES, stream>>>(p, ph, ph + 1);
#endif
}
```
